# Optimizing an MI355X kernel written in HIP

```python
import jax, jax.numpy as jnp
from jax import lax
import numpy as np

D_MODEL = 1024
BATCH = 4
SEQ = 4096
DEPTH = 1

N_HEADS_A = 8
HEAD_DIM_A = 64
V_DIM_A = 2 * HEAD_DIM_A
QK_WIDTH_A = N_HEADS_A * 2 * HEAD_DIM_A
WIDTH_A = N_HEADS_A * V_DIM_A
Q_BLOCK = 128
CHUNK = 128
N_GROUPS_B = 8
GROUP_DIM_B = 128
WIDTH_B = N_GROUPS_B * GROUP_DIM_B
SECTION_SIZES = (QK_WIDTH_A, QK_WIDTH_A, WIDTH_A, WIDTH_A, WIDTH_B, WIDTH_B, WIDTH_B, D_MODEL, D_MODEL)
IN_WIDTH = 3 * QK_WIDTH_A + WIDTH_A + 3 * WIDTH_B + 2 * D_MODEL
EPS = 1e-6
SUBLN_EPS = 1e-5
NEG_INF = -1e30

kernel_name = "hybrid_diffattn_gmlp_gated_block"


def rms_norm(x, g, eps=EPS):
    xf = x.astype(jnp.float32)
    y = xf * lax.rsqrt(jnp.mean(xf * xf, axis=-1, keepdims=True) + eps)
    return (y * g.astype(jnp.float32)).astype(x.dtype)


def layer_norm(x, g, b, eps=EPS):
    xf = x.astype(jnp.float32)
    mu = jnp.mean(xf, axis=-1, keepdims=True)
    var = jnp.mean(jnp.square(xf - mu), axis=-1, keepdims=True)
    y = (xf - mu) * lax.rsqrt(var + eps)
    return (y * g.astype(jnp.float32) + b.astype(jnp.float32)).astype(x.dtype)


def alibi_slopes(n_heads):
    return 2.0 ** (-8.0 * jnp.arange(1, n_heads + 1, dtype=jnp.float32) / n_heads)


def diff_attention(q, k, v, lam, slopes):
    B, S, H, _, dh = q.shape
    nb = S // Q_BLOCK
    scale = HEAD_DIM_A ** -0.5
    q_blocks = q.reshape(B, nb, Q_BLOCK, H, 2, dh).transpose(1, 0, 2, 3, 4, 5)
    k_pos = jnp.arange(S)

    def one_block(args):
        qi, i = args
        q_pos = i * Q_BLOCK + jnp.arange(Q_BLOCK)
        dist_i = q_pos[:, None] - k_pos[None, :]
        causal = dist_i >= 0
        s = jnp.einsum('bqhmd,bkhmd->bhmqk', qi, k,
                       preferred_element_type=jnp.float32) * scale
        s = s - slopes[None, :, None, None, None] * dist_i.astype(jnp.float32)
        s = jnp.where(causal, s, NEG_INF)
        p = jax.nn.softmax(s, axis=-1)
        a = p[:, :, 0] - lam * p[:, :, 1]
        return jnp.einsum('bhqk,bkhe->bqhe', a.astype(v.dtype), v)

    o = lax.map(one_block, (q_blocks, jnp.arange(nb)))
    return o.transpose(1, 0, 2, 3, 4).reshape(B, S, H, v.shape[-1])


def spatial_gating(u, vb, ln_g, ln_b, w_s, b_s):
    B, S, _ = u.shape
    nc = S // CHUNK
    vn = layer_norm(vb, ln_g, ln_b)
    vr = vn.reshape(B, nc, CHUNK, N_GROUPS_B, GROUP_DIM_B)
    tri = jnp.tril(jnp.ones((CHUNK, CHUNK), dtype=w_s.dtype))
    w_causal = w_s * tri[None]
    mixed = jnp.einsum('gts,bcsgd->bctgd', w_causal, vr) + b_s.T[None, None, :, :, None]
    return u * mixed.reshape(B, S, WIDTH_B)


def setup_inputs(seed: int = 0) -> dict:
    key = jax.random.key(seed)
    ks = jax.random.split(key, 20)
    f32 = jnp.float32
    nrm = lambda k, shp, s: jax.random.normal(k, shp, f32) * s
    return {
        "x": jax.random.normal(ks[0], (BATCH, SEQ, D_MODEL), f32),
        "norm_g": 1.0 + nrm(ks[1], (DEPTH, D_MODEL), 0.02),
        "w_in": nrm(ks[2], (DEPTH, D_MODEL, IN_WIDTH), D_MODEL ** -0.5),
        "lam_q1": nrm(ks[3], (DEPTH, HEAD_DIM_A), 0.1),
        "lam_k1": nrm(ks[4], (DEPTH, HEAD_DIM_A), 0.1),
        "lam_q2": nrm(ks[5], (DEPTH, HEAD_DIM_A), 0.1),
        "lam_k2": nrm(ks[6], (DEPTH, HEAD_DIM_A), 0.1),
        "subln_g": 1.0 + nrm(ks[7], (DEPTH, V_DIM_A), 0.02),
        "ln_b_g": 1.0 + nrm(ks[8], (DEPTH, WIDTH_B), 0.02),
        "ln_b_b": nrm(ks[9], (DEPTH, WIDTH_B), 0.02),
        "w_s": nrm(ks[10], (DEPTH, N_GROUPS_B, CHUNK, CHUNK), CHUNK ** -0.5),
        "b_s": 1.0 + nrm(ks[11], (DEPTH, N_GROUPS_B, CHUNK), 0.02),
        "w_a": nrm(ks[12], (DEPTH, WIDTH_A, D_MODEL), WIDTH_A ** -0.5),
        "w_b": nrm(ks[13], (DEPTH, WIDTH_B, D_MODEL), WIDTH_B ** -0.5),
        "w_out": nrm(ks[14], (DEPTH, D_MODEL, D_MODEL), D_MODEL ** -0.5),
        "final_g": 1.0 + nrm(ks[15], (D_MODEL,), 0.02),
    }


def reference(x, norm_g, w_in, lam_q1, lam_k1, lam_q2, lam_k2, subln_g, ln_b_g, ln_b_b,
              w_s, b_s, w_a, w_b, w_out, final_g):
    B, S, D = x.shape
    slopes = alibi_slopes(N_HEADS_A)
    split_idx = [int(i) for i in np.cumsum(SECTION_SIZES)[:-1]]
    for l in range(DEPTH):
        h = rms_norm(x, norm_g[l])
        proj = jnp.einsum('bsd,dc->bsc', h, w_in[l])
        q, k, v, z_a, u, vb, z_b, g_a, g_b = jnp.split(proj, split_idx, axis=-1)

        lam_init = 0.8 - 0.6 * np.exp(-0.3 * l)
        lam = (jnp.exp(jnp.sum(lam_q1[l].astype(jnp.float32) * lam_k1[l].astype(jnp.float32)))
               - jnp.exp(jnp.sum(lam_q2[l].astype(jnp.float32) * lam_k2[l].astype(jnp.float32)))
               + lam_init)
        qh = q.reshape(B, S, N_HEADS_A, 2, HEAD_DIM_A)
        kh = k.reshape(B, S, N_HEADS_A, 2, HEAD_DIM_A)
        vh = v.reshape(B, S, N_HEADS_A, V_DIM_A)
        o = diff_attention(qh, kh, vh, lam, slopes)
        o = rms_norm(o, subln_g[l], SUBLN_EPS) * (1.0 - lam_init)
        y_a = o.reshape(B, S, WIDTH_A) * jax.nn.silu(z_a)

        y_b = spatial_gating(jax.nn.gelu(u), jax.nn.gelu(vb), ln_b_g[l], ln_b_b[l],
                             w_s[l], b_s[l]) * jax.nn.silu(z_b)

        merged = (jax.nn.sigmoid(g_a) * jnp.einsum('bsc,cd->bsd', y_a, w_a[l])
                  + jax.nn.sigmoid(g_b) * jnp.einsum('bsc,cd->bsd', y_b, w_b[l]))
        x = x + jnp.einsum('bsd,de->bse', merged, w_out[l])
    return rms_norm(x, final_g)
```

```cpp
#include <hip/hip_runtime.h>
#include <hip/hip_cooperative_groups.h>
#include <cstdio>
#include <cstdint>
#include <cmath>
namespace cg = cooperative_groups;
namespace pg8 {
#define PG8_LAS __attribute__((address_space(3)))
typedef unsigned short bf16_t;
typedef short bf16x8 __attribute__((ext_vector_type(8)));
typedef float f32x4 __attribute__((ext_vector_type(4)));
typedef unsigned u32x4 __attribute__((ext_vector_type(4)));
constexpr int BM = 256, BK = 64, HALF = 128, HTB = HALF * BK * 2  , STAGE_BYTES = 8 * HTB, NXCD = 8, WGM = 8;

__host__ __device__ __forceinline__ int lds_byte(int r, int c) { const int st = (r >> 4) * 2 + (c >> 5), rr = r & 15, cc = c & 31, ob = rr * 64 + cc * 2; return st * 1024 + (ob ^ (((ob >> 9) & 1) << 5)); }
__host__ __device__ __forceinline__ void stage_rc(int b, int& R, int& C) { const int st = b / 1024, sb = b % 1024, swz = sb ^ (((sb >> 9) & 1) << 5); R = (st >> 1) * 16 + swz / 64; C = (st & 1) * 32 + (swz % 64) / 2; }
__host__ __device__ __forceinline__ int perm32(int rho) { const int n = rho >> 4, i = rho & 15; return 8 * (i >> 2) + 4 * n + (i & 3); }

struct Unit { int pm, pn; };
struct Gemm { const bf16_t* A; const bf16_t* Bt; int M, N, K; };

struct StaticOrder {
    int nM, nN, nwg, G, c;
    __host__ __device__ void init(int M, int N, int G_, int c_) { nM = M / BM; nN = N / BM; nwg = nM * nN; G = G_; c = c_; }
    __host__ __device__ bool next(int i, Unit& u) const {
        const long L = (long)i * G + c; if (L >= nwg) return false;
        int wgid = (int)L; { const int q = nwg / NXCD, r = nwg % NXCD, xcd = wgid % NXCD, off = wgid / NXCD; wgid = (xcd < r ? xcd * (q + 1) : r * (q + 1) + (xcd - r) * q) + off; }
        const int nig = WGM * nN, gid = wgid / nig, fm = gid * WGM, gsz = (nM - fm) < WGM ? (nM - fm) : WGM;
        u.pm = fm + ((wgid % nig) % gsz); u.pn = (wgid % nig) / gsz; return true;
    }
    __device__ __forceinline__ void a_ready(const Unit&) const {}
    __device__ __forceinline__ void done(const Unit&) const {}
};

__device__ __forceinline__ unsigned cvt_pk_bf16(float lo, float hi) { unsigned r; asm volatile("v_cvt_pk_bf16_f32 %0, %1, %2" : "=v"(r) : "v"(lo), "v"(hi)); return r; }
typedef float f32x2 __attribute__((ext_vector_type(2)));
template <class Epi, class Sched, bool ALIGN_EPI = false, bool SP2 = false>
__device__ __forceinline__ void gemm_phase(PG8_LAS unsigned char* lds, const Gemm g, const Sched& S, const Epi& E) {
    const int tid = threadIdx.x, wid = __builtin_amdgcn_readfirstlane(tid >> 6), lane = tid & 63, wr = wid >> 2, wc = wid & 3, fr = lane & 15, fq = lane >> 4;
    const int K = g.K, nt = K / BK;
    unsigned voffA[2], voffB[2];
#pragma unroll
    for (int i = 0; i < 2; ++i) { int R, C; stage_rc(tid * 16 + i * 8192, R, C); const int Rb = Epi::PERM ? ((R & ~31) + perm32(R & 31)) : R;
        voffA[i] = (unsigned)(R * K + C) * 2u; voffB[i] = (unsigned)(Rb * K + C) * 2u; }
    const size_t kstep = (size_t)(BK * 2);
    const size_t hstep = (size_t)HALF * K * 2;
    const size_t tstep = 2 * hstep;
    const unsigned ldsw = (unsigned)wid * 1024u;
    const int aoff = lds_byte(wr * 64 + fr, fq * 8), boff = lds_byte(wc * 32 + fr, fq * 8);
#define PG8_SA(b, h) (((b) * 2 + (h)) * HTB)
#define PG8_SB(b, h) ((4 + (b) * 2 + (h)) * HTB)
#define PG8_STAGE(bufoff, gbase, voff) do { _Pragma("unroll") for (int _i = 0; _i < 2; ++_i) \
        __builtin_amdgcn_global_load_lds((const unsigned*)((const char*)(gbase) + (voff)[_i]), (PG8_LAS unsigned*)(lds + (bufoff) + ldsw + _i * 8192), 16, 0, 0); } while (0)
#define PG8_LDA(dst, b, h) do { _Pragma("unroll") for (int m = 0; m < 4; ++m) _Pragma("unroll") for (int k = 0; k < 2; ++k) dst[m][k] = *(const PG8_LAS bf16x8*)(lds + PG8_SA(b, h) + aoff + m * 2048 + k * 1024); } while (0)
#define PG8_LDB(dst, b, h) do { _Pragma("unroll") for (int n = 0; n < 2; ++n) _Pragma("unroll") for (int k = 0; k < 2; ++k) dst[n][k] = *(const PG8_LAS bf16x8*)(lds + PG8_SB(b, h) + boff + n * 2048 + k * 1024); } while (0)
#define PG8_MMA(ai, bj, At, Bt) do { __builtin_amdgcn_s_setprio(1); _Pragma("unroll") for (int m = 0; m < 4; ++m) _Pragma("unroll") for (int n = 0; n < 2; ++n) _Pragma("unroll") for (int k = 0; k < 2; ++k) \
        acc[ai][bj][m][n] = __builtin_amdgcn_mfma_f32_16x16x32_bf16(Bt[n][k], At[m][k], acc[ai][bj][m][n], 0, 0, 0); __builtin_amdgcn_s_setprio(0); } while (0)
#define PG8_WAIT_V(n) asm volatile("s_waitcnt vmcnt(" #n ")" ::: "memory")
#define PG8_WAIT_L(n) asm volatile("s_waitcnt lgkmcnt(" #n ")" ::: "memory")
#define PG8_BAR __builtin_amdgcn_s_barrier()
#define PG8_SCHED __builtin_amdgcn_sched_barrier(0)
    Unit cur, nxt; int ui = 0;
    if (!S.next(0, cur)) return;
    f32x4 acc[2][2][4][2];
#pragma unroll
    for (int a = 0; a < 2; ++a)
#pragma unroll
        for (int b = 0; b < 2; ++b)
#pragma unroll
            for (int m = 0; m < 4; ++m)
#pragma unroll
                for (int n = 0; n < 2; ++n) acc[a][b][m][n] = (f32x4){0.f, 0.f, 0.f, 0.f};
    bf16x8 At[4][2], B0[2][2], B1[2][2];
    const char* cA = (const char*)g.A + (size_t)cur.pm * tstep; const char* cB = (const char*)g.Bt + (size_t)cur.pn * tstep;
    S.a_ready(cur);
    if constexpr (SP2) {
        PG8_STAGE(PG8_SB(0, 0), cB, voffB); PG8_STAGE(PG8_SB(0, 1), cB + hstep, voffB); PG8_STAGE(PG8_SA(0, 0), cA, voffA); PG8_STAGE(PG8_SA(0, 1), cA + hstep, voffA);
        if (wr == 1) PG8_BAR;
        PG8_WAIT_V(2); PG8_BAR;
        PG8_STAGE(PG8_SB(1, 0), cB + kstep, voffB); PG8_STAGE(PG8_SA(1, 0), cA + kstep, voffA); PG8_STAGE(PG8_SB(1, 1), cB + hstep + kstep, voffB);
        PG8_WAIT_V(6); PG8_BAR;
    } else {
        PG8_STAGE(PG8_SB(0, 0), cB, voffB); PG8_STAGE(PG8_SA(0, 0), cA, voffA); PG8_STAGE(PG8_SB(0, 1), cB + hstep, voffB); PG8_STAGE(PG8_SA(0, 1), cA + hstep, voffA);
        if (wr == 1) PG8_BAR;
        PG8_WAIT_V(4); PG8_BAR;
        PG8_STAGE(PG8_SB(1, 0), cB + kstep, voffB); PG8_STAGE(PG8_SA(1, 0), cA + kstep, voffA); PG8_STAGE(PG8_SB(1, 1), cB + hstep + kstep, voffB);
        PG8_WAIT_V(6); PG8_BAR;
    }
    for (;;) {
        const bool has_next = S.next(ui + 1, nxt);
        const char* nA = has_next ? (const char*)g.A + (size_t)nxt.pm * tstep : cA; const char* nB = has_next ? (const char*)g.Bt + (size_t)nxt.pn * tstep : cB;
        for (int t = 0; t < nt; t += 2) {
            const bool last = (t == nt - 2);
            const char* a1 = cA + (size_t)(t + 1) * kstep;
            const char* a2 = last ? nA : cA + (size_t)(t + 2) * kstep; const char* b2 = last ? nB : cB + (size_t)(t + 2) * kstep;
            const char* a3 = a2 + kstep; const char* b3 = b2 + kstep;
            if (last && has_next) S.a_ready(nxt);
            if constexpr (SP2) {
            PG8_LDB(B0, 0, 0); PG8_LDB(B1, 0, 1); PG8_SCHED; PG8_LDA(At, 0, 0); PG8_STAGE(PG8_SA(1, 1), a1 + hstep, voffA);
            PG8_WAIT_V(8); PG8_WAIT_L(0); PG8_BAR; PG8_MMA(0, 0, At, B0); PG8_MMA(0, 1, At, B1); PG8_BAR; PG8_SCHED;
            PG8_LDA(At, 0, 1); PG8_STAGE(PG8_SB(0, 0), b2, voffB); PG8_STAGE(PG8_SB(0, 1), b2 + hstep, voffB); PG8_STAGE(PG8_SA(0, 0), a2, voffA);
            PG8_WAIT_V(8); PG8_WAIT_L(0); PG8_BAR; PG8_MMA(1, 0, At, B0); PG8_MMA(1, 1, At, B1); PG8_BAR; PG8_SCHED;
            PG8_LDB(B0, 1, 0); PG8_LDB(B1, 1, 1); PG8_SCHED; PG8_LDA(At, 1, 0); PG8_STAGE(PG8_SA(0, 1), a2 + hstep, voffA);
            PG8_WAIT_V(8); PG8_WAIT_L(0); PG8_BAR; PG8_MMA(0, 0, At, B0); PG8_MMA(0, 1, At, B1); PG8_BAR; PG8_SCHED;
            PG8_LDA(At, 1, 1); PG8_STAGE(PG8_SB(1, 0), b3, voffB); PG8_STAGE(PG8_SB(1, 1), b3 + hstep, voffB); PG8_STAGE(PG8_SA(1, 0), a3, voffA);
            PG8_WAIT_V(8); PG8_WAIT_L(0); PG8_BAR; PG8_MMA(1, 0, At, B0); PG8_MMA(1, 1, At, B1); PG8_BAR; PG8_SCHED;
            } else {
            PG8_LDB(B0, 0, 0); PG8_SCHED; PG8_LDA(At, 0, 0); PG8_STAGE(PG8_SA(1, 1), a1 + hstep, voffA);
            PG8_WAIT_L(8); PG8_BAR; PG8_WAIT_L(0); PG8_MMA(0, 0, At, B0); PG8_BAR; PG8_SCHED;
            PG8_LDB(B1, 0, 1); PG8_STAGE(PG8_SB(0, 0), b2, voffB);
            PG8_BAR; PG8_WAIT_L(0); PG8_MMA(0, 1, At, B1); PG8_BAR;
            PG8_LDA(At, 0, 1); PG8_STAGE(PG8_SA(0, 0), a2, voffA);
            PG8_BAR; PG8_WAIT_L(0); PG8_MMA(1, 0, At, B0); PG8_BAR; PG8_SCHED;
            PG8_STAGE(PG8_SB(0, 1), b2 + hstep, voffB);
            PG8_WAIT_V(6); PG8_BAR; PG8_MMA(1, 1, At, B1); PG8_BAR;
            PG8_LDB(B0, 1, 0); PG8_SCHED; PG8_LDA(At, 1, 0); PG8_STAGE(PG8_SA(0, 1), a2 + hstep, voffA);
            PG8_WAIT_L(8); PG8_BAR; PG8_WAIT_L(0); PG8_MMA(0, 0, At, B0); PG8_BAR; PG8_SCHED;
            PG8_LDB(B1, 1, 1); PG8_STAGE(PG8_SB(1, 0), b3, voffB);
            PG8_BAR; PG8_WAIT_L(0); PG8_MMA(0, 1, At, B1); PG8_BAR;
            PG8_LDA(At, 1, 1); PG8_STAGE(PG8_SA(1, 0), a3, voffA);
            PG8_BAR; PG8_WAIT_L(0); PG8_MMA(1, 0, At, B0); PG8_BAR; PG8_SCHED;
            PG8_STAGE(PG8_SB(1, 1), b3 + hstep, voffB);
            PG8_WAIT_V(6); PG8_BAR; PG8_MMA(1, 1, At, B1); PG8_BAR;
            }
        }
        if constexpr (ALIGN_EPI) { if (wr == 0) PG8_BAR; }
        if constexpr (!Epi::AFTER_DRAIN) { E(acc, cur, wr, wc, fr, fq); S.done(cur); }
        if (!has_next) break;
#pragma unroll
        for (int a = 0; a < 2; ++a)
#pragma unroll
            for (int b = 0; b < 2; ++b)
#pragma unroll
                for (int m = 0; m < 4; ++m)
#pragma unroll
                    for (int n = 0; n < 2; ++n) acc[a][b][m][n] = (f32x4){0.f, 0.f, 0.f, 0.f};
        cur = nxt; cA = nA; cB = nB; ++ui;
        if constexpr (ALIGN_EPI) { if (wr == 1) PG8_BAR; }
    }
    PG8_WAIT_V(0);
    if constexpr (!ALIGN_EPI) { if (wr == 0) PG8_BAR; }
    PG8_BAR;
    if constexpr (Epi::AFTER_DRAIN) { E.fused(acc, cur, wr, wc, fr, fq, lds, wid, lane); S.done(cur); }
#undef PG8_SA
#undef PG8_SB
#undef PG8_STAGE
#undef PG8_LDA
#undef PG8_LDB
#undef PG8_MMA
#undef PG8_WAIT_V
#undef PG8_WAIT_L
#undef PG8_BAR
#undef PG8_SCHED
}
}

#ifndef MK_N_LAUNCHES
#define MK_N_LAUNCHES 1
#endif
constexpr int NB = 4, SEQ = 4096, DM = 1024, M = NB * SEQ, NIN = 9216;
constexpr int NWAVES = 8, NTHREADS = 512, N_PHASES = 6;
constexpr size_t MiB = 1u << 20;
constexpr size_t WS_CTL = 0, WS_WS = 1 * MiB, WS_PART = 2 * MiB, WS_PART2 = 4 * MiB, WS_WTA = 6 * MiB, WS_WTB = 8 * MiB, WS_WTO = 10 * MiB,
                 WS_WTIN = 12 * MiB, WS_H = 32 * MiB, WS_Q = 64 * MiB, WS_K = 96 * MiB, WS_V = 128 * MiB, WS_ZA = 160 * MiB, WS_UZ = 192 * MiB,
                 WS_GV = 224 * MiB, WS_END = 256 * MiB;
constexpr int RING_BYTES = 131072, LDS_BYTES = 147456;
constexpr float QSCALE = 0.125f * 1.4426950408889634f;
constexpr float LOG2E = 1.4426950408889634f;

#define LAS __attribute__((address_space(3)))
typedef unsigned short bf16;
typedef unsigned v4u __attribute__((ext_vector_type(4)));
typedef unsigned v2u __attribute__((ext_vector_type(2)));
typedef float f32x4 __attribute__((ext_vector_type(4)));
typedef float f32x2 __attribute__((ext_vector_type(2)));
typedef float f32x16 __attribute__((ext_vector_type(16)));
typedef short bf16x8 __attribute__((ext_vector_type(8)));
typedef short s16x4 __attribute__((ext_vector_type(4)));
typedef __bf16 bf16x2_t __attribute__((ext_vector_type(2)));

__device__ __forceinline__ unsigned pk2(float lo, float hi) { f32x2 v = {lo, hi}; bf16x2_t b = __builtin_convertvector(v, bf16x2_t); return __builtin_bit_cast(unsigned, b); }
__device__ __forceinline__ float bflo(unsigned u) { return __uint_as_float(u << 16); }
__device__ __forceinline__ float bfhi(unsigned u) { return __uint_as_float(u & 0xffff0000u); }
__device__ __forceinline__ float fast_sigmoid(float x) { return __builtin_amdgcn_rcpf(1.f + __builtin_amdgcn_exp2f(-LOG2E * x)); }
__device__ __forceinline__ float silu_f(float x) { return x * fast_sigmoid(x); }
__device__ __forceinline__ float gelu_tanh_f(float x) { return x * fast_sigmoid(1.5957691216057308f * (x + 0.044715f * x * x * x)); }
__device__ __forceinline__ float wave_sum(float v) {
#pragma unroll
    for (int o = 1; o < 64; o <<= 1) v += __shfl_xor(v, o);
    return v;
}
__device__ __forceinline__ int crow(int r, int hi) { return (r & 3) + 8 * (r >> 2) + 4 * hi; }

struct EpiInProj {
    static constexpr bool PERM = true, AFTER_DRAIN = false;
    bf16 *Q, *K, *V, *ZA, *UZ, *GV, *GA, *GB; float* part;
    template <int ACT> __device__ __forceinline__ void plain(const pg8::f32x4 (&acc)[2][2][4][2], bf16* base, int row0, int col0, int pn, int wc, int fq) const {
#pragma unroll
        for (int ai = 0; ai < 2; ++ai)
#pragma unroll
            for (int m = 0; m < 4; ++m) {
                const int row = row0 + ai * 128 + m * 16; bf16* rowp = base + (size_t)row * DM + col0;
                float s1 = 0.f, s2 = 0.f;
#pragma unroll
                for (int bj = 0; bj < 2; ++bj) {
                    float v[8];
#pragma unroll
                    for (int j = 0; j < 4; ++j) { v[j] = acc[ai][bj][m][0][j]; v[4 + j] = acc[ai][bj][m][1][j]; }
#pragma unroll
                    for (int j = 0; j < 8; ++j) {
                        if (ACT == 1) v[j] *= QSCALE;
                        if (ACT == 2) v[j] = silu_f(v[j]);
                        if (ACT == 3) { v[j] = gelu_tanh_f(v[j]); s1 += v[j]; s2 += v[j] * v[j]; }
                        if (ACT == 4) v[j] = fast_sigmoid(v[j]);
                    }
                    v4u w; w.x = pk2(v[0], v[1]); w.y = pk2(v[2], v[3]); w.z = pk2(v[4], v[5]); w.w = pk2(v[6], v[7]);
                    *(v4u*)(rowp + bj * 128) = w;
                }
                if (ACT == 3) {
                    s1 += __shfl_xor(s1, 16); s1 += __shfl_xor(s1, 32); s2 += __shfl_xor(s2, 16); s2 += __shfl_xor(s2, 32);
                    if (fq == 0) *(f32x2*)(part + ((size_t)row * 16 + (pn - 24) * 4 + wc) * 2) = (f32x2){s1, s2};
                }
            }
    }
    __device__ __forceinline__ void operator()(const pg8::f32x4 (&acc)[2][2][4][2], const pg8::Unit& u, int wr, int wc, int fr, int fq) const {
        const int pn = u.pn, row0 = u.pm * 256 + wr * 64 + fr, cw = wc * 32 + 8 * fq;
        if (pn >= 16 && pn < 24) {
            const int j = pn - 16;
#pragma unroll
            for (int ai = 0; ai < 2; ++ai)
#pragma unroll
                for (int m = 0; m < 4; ++m) {
                    const int row = row0 + ai * 128 + m * 16; float v[8];
#pragma unroll
                    for (int n = 0; n < 2; ++n)
#pragma unroll
                        for (int e = 0; e < 4; ++e) v[4 * n + e] = gelu_tanh_f(acc[ai][0][m][n][e]) * silu_f(acc[ai][1][m][n][e]);
                    v4u w; w.x = pk2(v[0], v[1]); w.y = pk2(v[2], v[3]); w.z = pk2(v[4], v[5]); w.w = pk2(v[6], v[7]);
                    *(v4u*)(UZ + (size_t)row * DM + j * 128 + cw) = w;
                }
            return;
        }
        const int sec = pn >> 2, col0 = (pn & 3) * 256 + cw;
        if (sec == 0) plain<1>(acc, Q, row0, col0, pn, wc, fq);
        else if (sec == 1) plain<0>(acc, K, row0, col0, pn, wc, fq);
        else if (sec == 2) plain<0>(acc, V, row0, col0, pn, wc, fq);
        else if (sec == 3) plain<2>(acc, ZA, row0, col0, pn, wc, fq);
        else if (sec == 6) plain<3>(acc, GV, row0, col0, pn, wc, fq);
        else if (sec == 7) plain<4>(acc, GA, row0, col0, pn, wc, fq);
        else plain<4>(acc, GB, row0, col0, pn, wc, fq);
    }
};
struct EpiMerge1 {
    static constexpr bool PERM = true, AFTER_DRAIN = false;
    const bf16* G; float* T;
    __device__ __forceinline__ void operator()(const pg8::f32x4 (&acc)[2][2][4][2], const pg8::Unit& u, int wr, int wc, int fr, int fq) const {
        const int row0 = u.pm * 256 + wr * 64 + fr, col0 = u.pn * 256 + wc * 32 + 8 * fq;
#pragma unroll
        for (int ai = 0; ai < 2; ++ai)
#pragma unroll
            for (int m = 0; m < 4; ++m)
#pragma unroll
                for (int bj = 0; bj < 2; ++bj) {
                    const size_t off = (size_t)(row0 + ai * 128 + m * 16) * DM + col0 + bj * 128;
                    const v4u g = *(const v4u*)(G + off);
                    f32x4 t0 = acc[ai][bj][m][0], t1 = acc[ai][bj][m][1];
                    t0[0] *= bflo(g.x); t0[1] *= bfhi(g.x); t0[2] *= bflo(g.y); t0[3] *= bfhi(g.y);
                    t1[0] *= bflo(g.z); t1[1] *= bfhi(g.z); t1[2] *= bflo(g.w); t1[3] *= bfhi(g.w);
                    *(f32x4*)(T + off) = t0; *(f32x4*)(T + off + 4) = t1;
                }
    }
};
struct EpiMerge2 {
    static constexpr bool PERM = true, AFTER_DRAIN = false;
    const bf16* G; const float* T; bf16* O;
    __device__ __forceinline__ void operator()(const pg8::f32x4 (&acc)[2][2][4][2], const pg8::Unit& u, int wr, int wc, int fr, int fq) const {
        const int row0 = u.pm * 256 + wr * 64 + fr, col0 = u.pn * 256 + wc * 32 + 8 * fq;
#pragma unroll
        for (int ai = 0; ai < 2; ++ai)
#pragma unroll
            for (int m = 0; m < 4; ++m)
#pragma unroll
                for (int bj = 0; bj < 2; ++bj) {
                    const size_t off = (size_t)(row0 + ai * 128 + m * 16) * DM + col0 + bj * 128;
                    const v4u g = *(const v4u*)(G + off);
                    f32x4 t0 = *(const f32x4*)(T + off), t1 = *(const f32x4*)(T + off + 4);
                    const f32x4 a0 = acc[ai][bj][m][0], a1 = acc[ai][bj][m][1];
                    t0[0] += a0[0] * bflo(g.x); t0[1] += a0[1] * bfhi(g.x); t0[2] += a0[2] * bflo(g.y); t0[3] += a0[3] * bfhi(g.y);
                    t1[0] += a1[0] * bflo(g.z); t1[1] += a1[1] * bfhi(g.z); t1[2] += a1[2] * bflo(g.w); t1[3] += a1[3] * bfhi(g.w);
                    v4u w; w.x = pk2(t0[0], t0[1]); w.y = pk2(t0[2], t0[3]); w.z = pk2(t1[0], t1[1]); w.w = pk2(t1[2], t1[3]);
                    *(v4u*)(O + off) = w;
                }
    }
};
struct EpiOut {
    static constexpr bool PERM = false, AFTER_DRAIN = false;
    const float* X; float* O; float* part2;
    __device__ __forceinline__ void operator()(const pg8::f32x4 (&acc)[2][2][4][2], const pg8::Unit& u, int wr, int wc, int fr, int fq) const {
        const int row0 = u.pm * 256 + wr * 64 + fr, col0 = u.pn * 256 + wc * 32 + 4 * fq;
#pragma unroll
        for (int ai = 0; ai < 2; ++ai)
#pragma unroll
            for (int m = 0; m < 4; ++m) {
                const int row = row0 + ai * 128 + m * 16; float s2 = 0.f;
#pragma unroll
                for (int bj = 0; bj < 2; ++bj)
#pragma unroll
                    for (int n = 0; n < 2; ++n) {
                        const size_t off = (size_t)row * DM + col0 + bj * 128 + n * 16;
                        const f32x4 v = *(const f32x4*)(X + off) + acc[ai][bj][m][n];
                        s2 += (v[0] * v[0] + v[1] * v[1]) + (v[2] * v[2] + v[3] * v[3]);
                        *(f32x4*)(O + off) = v;
                    }
                s2 += __shfl_xor(s2, 16); s2 += __shfl_xor(s2, 32);
                if (fq == 0) part2[(size_t)row * 16 + u.pn * 4 + wc] = s2;
            }
    }
};

__device__ __forceinline__ int win_src_col(int n) {
    const int pn = n >> 8, cc = n & 255;
    if (pn < 16) return n;
    if (pn < 24) { const int j = pn - 16; return cc < 128 ? 4096 + 128 * j + cc : 6144 + 128 * j + (cc - 128); }
    if (pn < 28) return 5120 + (n - 24 * 256);
    return 7168 + (n - 28 * 256);
}
__device__ __forceinline__ void p0_transpose_item(const float* W, int K, int N, bf16* WT, bool permute, LAS float* scr, int item, int lane) {
    const int nblk = N / 32, kb = item / nblk, nb = item % nblk, k0 = 64 * kb, n0 = 32 * nb;
    const int n0s = permute ? win_src_col(n0) : n0;
#pragma unroll 8
    for (int i = 0; i < 32; ++i) { const int kk = 2 * i + (lane >> 5); scr[kk * 33 + (lane & 31)] = W[(size_t)(k0 + kk) * N + n0s + (lane & 31)]; }
    asm volatile("s_waitcnt lgkmcnt(0)" ::: "memory");
    const int c = lane & 7;
#pragma unroll
    for (int j = 0; j < 4; ++j) { const int n = (lane >> 3) + 8 * j; const LAS float* s = scr + (8 * c) * 33 + n;
        v4u o; o.x = pk2(s[0 * 33], s[1 * 33]); o.y = pk2(s[2 * 33], s[3 * 33]); o.z = pk2(s[4 * 33], s[5 * 33]); o.w = pk2(s[6 * 33], s[7 * 33]);
        *(v4u*)(WT + (size_t)(n0 + n) * K + k0 + 8 * c) = o; }
    asm volatile("s_waitcnt lgkmcnt(0)" ::: "memory");
}

struct Args { const float* in[16]; float* out; unsigned char* ws; int ph_lo, ph_hi; };

__device__ __forceinline__ void p0_prologue(const Args& a, LAS unsigned char* lds, int vcu, int G, int wave, int lane) {
    unsigned char* ws = a.ws;
    LAS float* scr = (LAS float*)(lds + wave * 16384);
    const int gw = vcu * NWAVES + wave, NGW = G * NWAVES;
    constexpr int I_IN = (DM / 64) * (NIN / 32), I_SQ = (DM / 64) * (DM / 32);
    constexpr int NITEMS = I_IN + 3 * I_SQ;
    for (int it = gw; it < NITEMS; it += NGW) {
        int r = it;
        if (r < I_IN) { p0_transpose_item(a.in[2], DM, NIN, (bf16*)(ws + WS_WTIN), true, scr, r, lane); continue; } r -= I_IN;
        if (r < I_SQ) { p0_transpose_item(a.in[12], DM, DM, (bf16*)(ws + WS_WTA), false, scr, r, lane); continue; } r -= I_SQ;
        if (r < I_SQ) { p0_transpose_item(a.in[13], DM, DM, (bf16*)(ws + WS_WTB), false, scr, r, lane); continue; } r -= I_SQ;
        p0_transpose_item(a.in[14], DM, DM, (bf16*)(ws + WS_WTO), false, scr, r, lane);
    }
    const float* x = a.in[0]; const float* ng = a.in[1]; bf16* H = (bf16*)(ws + WS_H);
    f32x4 g4[4];
#pragma unroll
    for (int j = 0; j < 4; ++j) g4[j] = ((const f32x4*)ng)[64 * j + lane];
    for (int m = gw; m < M; m += NGW) {
        const f32x4* xr = (const f32x4*)(x + (size_t)m * DM) + lane; f32x4 v[4]; float s = 0.f;
#pragma unroll
        for (int j = 0; j < 4; ++j) { v[j] = xr[64 * j]; s += (v[j][0] * v[j][0] + v[j][1] * v[j][1]) + (v[j][2] * v[j][2] + v[j][3] * v[j][3]); }
        const float rstd = 1.0f / sqrtf(wave_sum(s) * (1.f / DM) + 1e-6f);
        v2u* o8 = (v2u*)(H + (size_t)m * DM) + lane;
#pragma unroll
        for (int j = 0; j < 4; ++j) { const f32x4 y = v[j] * rstd * g4[j]; o8[64 * j] = (v2u){pk2(y[0], y[1]), pk2(y[2], y[3])}; }
    }
    const float* w_s = a.in[10]; bf16* WSb = (bf16*)(ws + WS_WS);
    for (int i = gw * 64 + lane; i < 8 * 128 * 128; i += NGW * 64) { const int t = (i >> 7) & 127, s = i & 127; const float v = (s <= t) ? w_s[i] : 0.f; WSb[i] = (bf16)(pk2(v, 0.f) & 0xffffu); }
    if (gw == 0) {
        const float sa = wave_sum(a.in[3][lane] * a.in[4][lane]), sb = wave_sum(a.in[5][lane] * a.in[6][lane]);
        if (lane == 0) ((float*)(ws + WS_CTL))[0] = expf(sa) - expf(sb) + 0.2f;
    }
}

namespace att {
constexpr int L_K = 0, L_V = 16384, L_WSF = 49152, L_ST = 53248, L_END = L_ST + 65536;
__device__ __forceinline__ s16x4 vtr(const LAS unsigned char* p) { typedef short v4i16_t __attribute__((ext_vector_type(4))); return __builtin_bit_cast(s16x4, __builtin_amdgcn_ds_read_tr16_b64_v4i16((LAS v4i16_t*)p)); }
#define MFMA32(a, b, c) __builtin_amdgcn_mfma_f32_32x32x16_bf16((a), (b), (c), 0, 0, 0)

__device__ __forceinline__ void sweep(f32x16 (&o)[4], const bf16* Qm, const bf16* Km, const bf16* Vh, int q0, int NT, float sl, LAS unsigned char* lds, int tid, int wid, int lane, int r32, int hi) {
    const int qrow = q0 + wid * 32 + r32;
    bf16x8 qr[4];
#pragma unroll
    for (int d0 = 0; d0 < 4; ++d0) qr[d0] = *(const bf16x8*)(Qm + (size_t)qrow * DM + d0 * 16 + hi * 8);
#pragma unroll
    for (int e = 0; e < 4; ++e)
#pragma unroll
        for (int i = 0; i < 16; ++i) o[e][i] = 0.f;
    float mhat = 0.f, lsum = 0.f;
    LAS float* wsf = (LAS float*)(lds + L_WSF) + wid * 64;
    const unsigned koff = (unsigned)(lane * DM + wid * 8);
    const unsigned voff0 = (unsigned)((16 * (wid & 3) + (lane >> 2)) * DM + (wid >> 2) * 32 + (lane & 3) * 8), voff1 = voff0 + 64;
#define ATT_STAGE(tt, bb) do { const bf16* Kt_ = Km + (size_t)(tt) * 64 * DM; const bf16* Vt_ = Vh + (size_t)(tt) * 64 * DM; \
        __builtin_amdgcn_global_load_lds((const unsigned*)(Kt_ + koff), (LAS unsigned*)(lds + L_K + (bb) * 8192 + wid * 1024), 16, 0, 0); \
        __builtin_amdgcn_global_load_lds((const unsigned*)(Vt_ + voff0), (LAS unsigned*)(lds + L_V + (bb) * 16384 + wid * 1024), 16, 0, 0); \
        __builtin_amdgcn_global_load_lds((const unsigned*)(Vt_ + voff1), (LAS unsigned*)(lds + L_V + (bb) * 16384 + 8192 + wid * 1024), 16, 0, 0); } while (0)
    ATT_STAGE(0, 0);
    asm volatile("s_waitcnt vmcnt(0)" ::: "memory");
    __syncthreads();
    const int voff = ((lane >> 4) & 1) * 32 + (lane & 3) * 8 + (4 * hi + ((lane & 15) >> 2)) * 64;
    const int qmin_w = q0 + wid * 32;
    for (int t = 0; t < NT; ++t) {
        const int buf = t & 1;
        if (t + 1 < NT) ATT_STAGE(t + 1, buf ^ 1);
        if (64 * t <= qmin_w + 31) {
            const LAS unsigned char* Kb = lds + L_K + buf * 8192 + hi * 1024 + r32 * 16;
            f32x16 p0, p1;
#pragma unroll
            for (int i = 0; i < 16; ++i) { p0[i] = 0.f; p1[i] = 0.f; }
#pragma unroll
            for (int d0 = 0; d0 < 4; ++d0) {
                const bf16x8 a0 = *(const LAS bf16x8*)(Kb + d0 * 2048), a1 = *(const LAS bf16x8*)(Kb + d0 * 2048 + 512);
                p0 = MFMA32(a0, qr[d0], p0); p1 = MFMA32(a1, qr[d0], p1);
            }
            const float base = sl * (float)(64 * t + 4 * hi - qrow);
#pragma unroll
            for (int i = 0; i < 16; ++i) { const float n_i = (float)((i & 3) + 8 * (i >> 2)); p0[i] += base + sl * n_i; p1[i] += base + sl * (n_i + 32.f); }
            if (64 * t + 63 > qmin_w) {
#pragma unroll
                for (int i = 0; i < 16; ++i) { const int kv = 64 * t + crow(i, hi); if (kv > qrow) p0[i] = -INFINITY; if (kv + 32 > qrow) p1[i] = -INFINITY; }
            }
            float rm = fmaxf(p0[0], p1[0]);
#pragma unroll
            for (int i = 1; i < 16; ++i) rm = fmaxf(rm, fmaxf(p0[i], p1[i]));
            rm = fmaxf(rm, __shfl_xor(rm, 32));
            if (t == 0) mhat = rm;
            else if (__any(rm > mhat + 8.f)) {
                const float nm = fmaxf(mhat, rm), f = __builtin_amdgcn_exp2f(mhat - nm); mhat = nm; lsum *= f;
                if (hi == 0) wsf[r32] = f;
                asm volatile("s_waitcnt lgkmcnt(0)" ::: "memory");
#pragma unroll
                for (int i = 0; i < 16; ++i) { const float fi = wsf[crow(i, hi)];
#pragma unroll
                    for (int e = 0; e < 4; ++e) o[e][i] *= fi; }
            }
            float ls = 0.f;
#pragma unroll
            for (int i = 0; i < 16; ++i) { p0[i] = __builtin_amdgcn_exp2f(p0[i] - mhat); p1[i] = __builtin_amdgcn_exp2f(p1[i] - mhat); ls += p0[i] + p1[i]; }
            lsum += ls;
            bf16x8 pa[4];
            { v4u w;
              w.x = pk2(p0[0], p0[1]); w.y = pk2(p0[2], p0[3]); w.z = pk2(p0[4], p0[5]); w.w = pk2(p0[6], p0[7]); pa[0] = __builtin_bit_cast(bf16x8, w);
              w.x = pk2(p0[8], p0[9]); w.y = pk2(p0[10], p0[11]); w.z = pk2(p0[12], p0[13]); w.w = pk2(p0[14], p0[15]); pa[1] = __builtin_bit_cast(bf16x8, w);
              w.x = pk2(p1[0], p1[1]); w.y = pk2(p1[2], p1[3]); w.z = pk2(p1[4], p1[5]); w.w = pk2(p1[6], p1[7]); pa[2] = __builtin_bit_cast(bf16x8, w);
              w.x = pk2(p1[8], p1[9]); w.y = pk2(p1[10], p1[11]); w.z = pk2(p1[12], p1[13]); w.w = pk2(p1[14], p1[15]); pa[3] = __builtin_bit_cast(bf16x8, w); }
            const LAS unsigned char* Vb = lds + L_V + buf * 16384 + voff;
#pragma unroll
            for (int e = 0; e < 4; ++e) {
#pragma unroll
                for (int s = 0; s < 4; ++s) {
                    const s16x4 lo = vtr(Vb + e * 4096 + s * 1024), hh = vtr(Vb + e * 4096 + s * 1024 + 512);
                    const bf16x8 vf = __builtin_shufflevector(lo, hh, 0, 1, 2, 3, 4, 5, 6, 7);
                    o[e] = MFMA32(pa[s], vf, o[e]);
                }
                __builtin_amdgcn_sched_barrier(0);
            }
        }
        asm volatile("s_waitcnt vmcnt(0)" ::: "memory");
        __syncthreads();
    }
    lsum += __shfl_xor(lsum, 32);
    if (hi == 0) wsf[32 + r32] = lsum;
    asm volatile("s_waitcnt lgkmcnt(0)" ::: "memory");
#pragma unroll
    for (int i = 0; i < 16; ++i) { const float rl = 1.0f / wsf[32 + crow(i, hi)];
#pragma unroll
        for (int e = 0; e < 4; ++e) o[e][i] *= rl; }
    asm volatile("s_waitcnt lgkmcnt(0)" ::: "memory");
}

__device__ __forceinline__ void unit(int b, int h, int qb, bf16* Q, const bf16* K, const bf16* V, const bf16* ZA, const float* subg, float lam, LAS unsigned char* lds) {
    const int tid = threadIdx.x, lane = tid & 63, r32 = lane & 31, hi = lane >> 5, wid = __builtin_amdgcn_readfirstlane(tid >> 6);
    const size_t rowbase = (size_t)b * SEQ; const int q0 = qb * 256, NT = 4 * (qb + 1);
    const float sl = exp2f(-(float)(h + 1)) * LOG2E;
    f32x16 o[4];
    LAS unsigned* stw = (LAS unsigned*)(lds + L_ST) + wid * 2048 + lane;
    sweep(o, Q + rowbase * DM + h * 128, K + rowbase * DM + h * 128, V + rowbase * DM + h * 128, q0, NT, sl, lds, tid, wid, lane, r32, hi);
#pragma unroll
    for (int e = 0; e < 4; ++e)
#pragma unroll
        for (int i = 0; i < 8; ++i) stw[(e * 8 + i) * 64] = pk2(o[e][2 * i], o[e][2 * i + 1]);
    sweep(o, Q + rowbase * DM + h * 128 + 64, K + rowbase * DM + h * 128 + 64, V + rowbase * DM + h * 128, q0, NT, sl, lds, tid, wid, lane, r32, hi);
    float ssq[16];
#pragma unroll
    for (int e = 0; e < 4; ++e)
#pragma unroll
        for (int i = 0; i < 8; ++i) { const unsigned w = stw[(e * 8 + i) * 64];
            o[e][2 * i] = bflo(w) - lam * o[e][2 * i]; o[e][2 * i + 1] = bfhi(w) - lam * o[e][2 * i + 1]; }
#pragma unroll
    for (int i = 0; i < 16; ++i) { float s = 0.f;
#pragma unroll
        for (int e = 0; e < 4; ++e) s += o[e][i] * o[e][i];
#pragma unroll
        for (int x = 1; x < 32; x <<= 1) s += __shfl_xor(s, x);
        ssq[i] = 0.8f / sqrtf(s * (1.f / 128.f) + 1e-5f); }
    asm volatile("s_waitcnt lgkmcnt(0)" ::: "memory");
    LAS bf16* stg = (LAS bf16*)(lds + L_ST) + wid * 4096;
#pragma unroll
    for (int e = 0; e < 4; ++e) { const float gs = subg[32 * e + r32];
#pragma unroll
        for (int i = 0; i < 16; ++i) stg[crow(i, hi) * 128 + 32 * e + r32] = (bf16)(pk2(o[e][i] * ssq[i] * gs, 0.f) & 0xffffu); }
    asm volatile("s_waitcnt lgkmcnt(0)" ::: "memory");
    bf16* Y = Q;
#pragma unroll
    for (int it = 0; it < 8; ++it) {
        const int row = it * 4 + (lane >> 4), ch = lane & 15;
        const size_t off = (rowbase + q0 + wid * 32 + row) * DM + h * 128 + ch * 8;
        const v4u yv = *(const LAS v4u*)(stg + row * 128 + ch * 8), zv = *(const v4u*)(ZA + off);
        v4u w;
        w.x = pk2(bflo(yv.x) * bflo(zv.x), bfhi(yv.x) * bfhi(zv.x)); w.y = pk2(bflo(yv.y) * bflo(zv.y), bfhi(yv.y) * bfhi(zv.y));
        w.z = pk2(bflo(yv.z) * bflo(zv.z), bfhi(yv.z) * bfhi(zv.z)); w.w = pk2(bflo(yv.w) * bflo(zv.w), bfhi(yv.w) * bfhi(zv.w));
        *(v4u*)(Y + off) = w;
    }
    asm volatile("s_waitcnt lgkmcnt(0)" ::: "memory");
}
}

namespace gm {
constexpr int L_VN = 0, L_ST = 32768;
__device__ __forceinline__ void unit(int chunk, int g, bf16* UZ, const bf16* GV, const float* part, const bf16* WSb, const float* lng, const float* lnb, const float* b_s, LAS unsigned char* lds) {
    const int tid = threadIdx.x, lane = tid & 63, r32 = lane & 31, hi = lane >> 5, wid = __builtin_amdgcn_readfirstlane(tid >> 6);
    const size_t row0 = (size_t)chunk * 128;
    LAS float* stt = (LAS float*)(lds + L_ST);
    if (tid < 128) {
        const float* p = part + (row0 + tid) * 32; float s1 = 0.f, s2 = 0.f;
#pragma unroll
        for (int j = 0; j < 16; ++j) { s1 += p[2 * j]; s2 += p[2 * j + 1]; }
        const float mu = s1 * (1.f / 1024.f), var = fmaxf(s2 * (1.f / 1024.f) - mu * mu, 0.f);
        stt[2 * tid] = mu; stt[2 * tid + 1] = 1.0f / sqrtf(var + 1e-6f);
    }
    __syncthreads();
#pragma unroll
    for (int it = 0; it < 4; ++it) {
        const int idx = tid + 512 * it, s = idx >> 4, c16 = idx & 15;
        const v4u raw = *(const v4u*)(GV + (row0 + s) * DM + g * 128 + c16 * 8);
        const float mu = stt[2 * s], rs = stt[2 * s + 1];
        const f32x4 ga = *(const f32x4*)(lng + g * 128 + c16 * 8), gb = *(const f32x4*)(lng + g * 128 + c16 * 8 + 4);
        const f32x4 ba = *(const f32x4*)(lnb + g * 128 + c16 * 8), bb = *(const f32x4*)(lnb + g * 128 + c16 * 8 + 4);
        float v[8] = {bflo(raw.x), bfhi(raw.x), bflo(raw.y), bfhi(raw.y), bflo(raw.z), bfhi(raw.z), bflo(raw.w), bfhi(raw.w)};
#pragma unroll
        for (int j = 0; j < 4; ++j) { v[j] = (v[j] - mu) * rs * ga[j] + ba[j]; v[4 + j] = (v[4 + j] - mu) * rs * gb[j] + bb[j]; }
        v4u w; w.x = pk2(v[0], v[1]); w.y = pk2(v[2], v[3]); w.z = pk2(v[4], v[5]); w.w = pk2(v[6], v[7]);
        *(LAS v4u*)(lds + L_VN + (s >> 6) * 16384 + (c16 >> 2) * 4096 + (s & 63) * 64 + (c16 & 3) * 16) = w;
    }
    __syncthreads();
    const int tb = wid >> 1, db0 = 2 * (wid & 1);
    f32x16 acc[2];
#pragma unroll
    for (int i = 0; i < 16; ++i) { acc[0][i] = 0.f; acc[1][i] = 0.f; }
    const bf16* wrow = WSb + ((size_t)g * 128 + tb * 32 + r32) * 128;
    const int voff = ((lane >> 4) & 1) * 32 + (lane & 3) * 8 + (4 * hi + ((lane & 15) >> 2)) * 64;
#pragma unroll
    for (int ks = 0; ks < 8; ++ks) {
        if (ks * 16 > tb * 32 + 31) continue;
        const v2u a_lo = *(const v2u*)(wrow + 16 * ks + 4 * hi), a_hi = *(const v2u*)(wrow + 16 * ks + 8 + 4 * hi);
        const v4u aw = {a_lo.x, a_lo.y, a_hi.x, a_hi.y}; const bf16x8 af = __builtin_bit_cast(bf16x8, aw);
        const LAS unsigned char* Vb = lds + L_VN + (ks >> 2) * 16384 + (ks & 3) * 1024 + voff;
#pragma unroll
        for (int d = 0; d < 2; ++d) {
            const s16x4 lo = att::vtr(Vb + (db0 + d) * 4096), hh = att::vtr(Vb + (db0 + d) * 4096 + 512);
            const bf16x8 vf = __builtin_shufflevector(lo, hh, 0, 1, 2, 3, 4, 5, 6, 7);
            acc[d] = MFMA32(af, vf, acc[d]);
        }
    }
#pragma unroll
    for (int i = 0; i < 16; ++i) {
        const int t = tb * 32 + crow(i, hi); const float bs = b_s[g * 128 + t];
#pragma unroll
        for (int d = 0; d < 2; ++d) {
            const size_t off = (row0 + t) * DM + g * 128 + (db0 + d) * 32 + r32;
            const float uz = bflo((unsigned)UZ[off]);
            const float y = uz * (acc[d][i] + bs);
            UZ[off] = (bf16)(pk2(y, 0.f) & 0xffffu);
        }
    }
    __syncthreads();
}
}

__global__ void __launch_bounds__(NTHREADS, 2) fwd_kernel(Args args) {
    extern __shared__ __attribute__((aligned(16))) unsigned char lds_raw[];
    LAS unsigned char* lds = (LAS unsigned char*)lds_raw;
    cg::grid_group grid = cg::this_grid();
    const int tid = threadIdx.x, lane = tid & 63, wave = __builtin_amdgcn_readfirstlane(tid >> 6);
    const int G = gridDim.x, bx = blockIdx.x, vcu = (G % 8 == 0) ? (bx % 8) * (G / 8) + bx / 8 : bx;
    unsigned char* ws = args.ws;
    const int lo = args.ph_lo, hi_ph = args.ph_hi;
#define IN(k) (lo <= (k) && (k) < hi_ph)
#define SEAM(k) do { if (IN(k) && IN((k) + 1)) grid.sync(); } while (0)
    bf16 *Hb = (bf16*)(ws + WS_H), *Qb = (bf16*)(ws + WS_Q), *Kb = (bf16*)(ws + WS_K), *Vb = (bf16*)(ws + WS_V), *ZAb = (bf16*)(ws + WS_ZA), *UZb = (bf16*)(ws + WS_UZ), *GVb = (bf16*)(ws + WS_GV);
    bf16 *GAb = (bf16*)args.out, *GBb = (bf16*)args.out + (size_t)M * DM;
    float* part = (float*)(ws + WS_PART); float* part2 = (float*)(ws + WS_PART2);

    if (IN(0)) { p0_prologue(args, lds, vcu, G, wave, lane); }
    SEAM(0);
    if (IN(1)) {
        pg8::Gemm g{Hb, (const bf16*)(ws + WS_WTIN), M, NIN, DM}; pg8::StaticOrder S; S.init(M, NIN, G, bx);
        EpiInProj E{Qb, Kb, Vb, ZAb, UZb, GVb, GAb, GBb, part};
        pg8::gemm_phase<EpiInProj, pg8::StaticOrder, true, true>(lds, g, S, E);
    }
    SEAM(1);
    if (IN(2)) {
        const float lam = ((const float*)(ws + WS_CTL))[0];
        for (int pi = vcu; pi < 256; pi += G) {
            const int bh = pi >> 3, s = pi & 7;
#ifndef NO_ATT
            att::unit(bh >> 3, bh & 7, 15 - s, Qb, Kb, Vb, ZAb, args.in[7], lam, lds);
            att::unit(bh >> 3, bh & 7, s, Qb, Kb, Vb, ZAb, args.in[7], lam, lds);
#endif
        }
        for (int u = vcu; u < 1024; u += G) gm::unit(u >> 3, u & 7, UZb, GVb, part, (const bf16*)(ws + WS_WS), args.in[8], args.in[9], args.in[11], lds);
    }
    SEAM(2);
    if (IN(3)) {
        float* T = (float*)(ws + WS_K);
        { pg8::Gemm g{Qb, (const bf16*)(ws + WS_WTA), M, DM, DM}; pg8::StaticOrder S; S.init(M, DM, G, bx); EpiMerge1 E{GAb, T};
          pg8::gemm_phase<EpiMerge1, pg8::StaticOrder, true, true>(lds, g, S, E); }
        __syncthreads();
        { pg8::Gemm g{UZb, (const bf16*)(ws + WS_WTB), M, DM, DM}; pg8::StaticOrder S; S.init(M, DM, G, bx); EpiMerge2 E{GBb, T, Hb};
          pg8::gemm_phase<EpiMerge2, pg8::StaticOrder, true, true>(lds, g, S, E); }
    }
    SEAM(3);
    if (IN(4)) {
        pg8::Gemm g{Hb, (const bf16*)(ws + WS_WTO), M, DM, DM}; pg8::StaticOrder S; S.init(M, DM, G, bx); EpiOut E{args.in[0], args.out, part2};
        pg8::gemm_phase<EpiOut, pg8::StaticOrder, true, true>(lds, g, S, E);
    }
    SEAM(4);
    if (IN(5)) {
        const int gw = vcu * NWAVES + wave, NGW = G * NWAVES; const float* fg = args.in[15];
        f32x4 g4[4];
#pragma unroll
        for (int j = 0; j < 4; ++j) g4[j] = ((const f32x4*)fg)[64 * j + lane];
        for (int m = gw; m < M; m += NGW) {
            float s = (lane < 16) ? part2[(size_t)m * 16 + lane] : 0.f;
            s = wave_sum(s);
            const float rstd = 1.0f / sqrtf(s * (1.f / DM) + 1e-6f);
            f32x4* xr = (f32x4*)(args.out + (size_t)m * DM) + lane;
#pragma unroll
            for (int j = 0; j < 4; ++j) xr[64 * j] = xr[64 * j] * rstd * g4[j];
        }
    }
#undef IN
#undef SEAM
}

extern "C" void kernel_launch(void* const* d_in, const int* in_sizes, int n_in, void* d_out, int out_size, void* d_ws, size_t ws_size, hipStream_t stream) {
    static int grid = 0;
    if (grid == 0) {
        if (n_in != 16 || out_size != M * DM || ws_size < WS_END) { fprintf(stderr, "kernel_launch: unexpected shapes (n_in %d out %d ws %zu)\n", n_in, out_size, ws_size); grid = -1; return; }
        int dev = 0, cus = 0, per_cu = 0;
        hipGetDevice(&dev); hipDeviceGetAttribute(&cus, hipDeviceAttributeMultiprocessorCount, dev);
        hipFuncSetAttribute((const void*)fwd_kernel, hipFuncAttributeMaxDynamicSharedMemorySize, LDS_BYTES);
        hipOccupancyMaxActiveBlocksPerMultiprocessor(&per_cu, (const void*)fwd_kernel, NTHREADS, LDS_BYTES);
        if (per_cu < 1) per_cu = 1;
        grid = cus * per_cu;
        (void)hipGetLastError();
    }
    if (grid < 0) return;
    Args a{};
    for (int i = 0; i < 16; ++i) a.in[i] = (const float*)d_in[i];
    a.out = (float*)d_out; a.ws = (unsigned char*)d_ws;
#if MK_N_LAUNCHES == 1
    a.ph_lo = 0; a.ph_hi = N_PHASES;
    void* kargs[] = {&a};
    hipError_t e = hipLaunchCooperativeKernel((const void*)fwd_kernel, dim3(grid), dim3(NTHREADS), kargs, LDS_BYTES, stream);
    if (e != hipSuccess) fprintf(stderr, "cooperative launch failed: %s (grid %d)\n", hipGetErrorString(e), grid);
#else
    for (int p = 0; p < N_PHASES; ++p) { a.ph_lo = p; a.ph_hi = p + 1; hipLaunchKernelGGL(fwd_kernel, dim3(grid), dim3(NTHREADS), LDS_BYTES, stream, a); }
#endif
}
```

```cpp
#include <hip/hip_runtime.h>
#include <hip/hip_cooperative_groups.h>
#include <cstdio>
#include <cstdint>
#include <cmath>
namespace cg = cooperative_groups;
namespace pg8 {
#define PG8_LAS __attribute__((address_space(3)))
typedef unsigned short bf16_t;
typedef short bf16x8 __attribute__((ext_vector_type(8)));
typedef float f32x4 __attribute__((ext_vector_type(4)));
typedef unsigned u32x4 __attribute__((ext_vector_type(4)));
constexpr int BM = 256, BK = 64, HALF = 128, HTB = HALF * BK * 2  , STAGE_BYTES = 8 * HTB, NXCD = 8, WGM = 8;

__host__ __device__ __forceinline__ int lds_byte(int r, int c) { const int st = (r >> 4) * 2 + (c >> 5), rr = r & 15, cc = c & 31, ob = rr * 64 + cc * 2; return st * 1024 + (ob ^ (((ob >> 9) & 1) << 5)); }
__host__ __device__ __forceinline__ void stage_rc(int b, int& R, int& C) { const int st = b / 1024, sb = b % 1024, swz = sb ^ (((sb >> 9) & 1) << 5); R = (st >> 1) * 16 + swz / 64; C = (st & 1) * 32 + (swz % 64) / 2; }
__host__ __device__ __forceinline__ int perm32(int rho) { const int n = rho >> 4, i = rho & 15; return 8 * (i >> 2) + 4 * n + (i & 3); }

struct Unit { int pm, pn; };
struct Gemm { const bf16_t* A; const bf16_t* Bt; int M, N, K; };

struct StaticOrder {
    int nM, nN, nwg, G, c;
    __host__ __device__ void init(int M, int N, int G_, int c_) { nM = M / BM; nN = N / BM; nwg = nM * nN; G = G_; c = c_; }
    __host__ __device__ bool next(int i, Unit& u) const {
        const long L = (long)i * G + c; if (L >= nwg) return false;
        int wgid = (int)L; { const int q = nwg / NXCD, r = nwg % NXCD, xcd = wgid % NXCD, off = wgid / NXCD; wgid = (xcd < r ? xcd * (q + 1) : r * (q + 1) + (xcd - r) * q) + off; }
        const int nig = WGM * nN, gid = wgid / nig, fm = gid * WGM, gsz = (nM - fm) < WGM ? (nM - fm) : WGM;
        u.pm = fm + ((wgid % nig) % gsz); u.pn = (wgid % nig) / gsz; return true;
    }
    __device__ __forceinline__ void a_ready(const Unit&) const {}
    __device__ __forceinline__ void done(const Unit&) const {}
};

__device__ __forceinline__ unsigned cvt_pk_bf16(float lo, float hi) { unsigned r; asm volatile("v_cvt_pk_bf16_f32 %0, %1, %2" : "=v"(r) : "v"(lo), "v"(hi)); return r; }
typedef float f32x2 __attribute__((ext_vector_type(2)));
template <class Epi, class Sched, bool ALIGN_EPI = false, bool SP2 = false>
__device__ __forceinline__ void gemm_phase(PG8_LAS unsigned char* lds, const Gemm g, const Sched& S, const Epi& E) {
    const int tid = threadIdx.x, wid = __builtin_amdgcn_readfirstlane(tid >> 6), lane = tid & 63, wr = wid >> 2, wc = wid & 3, fr = lane & 15, fq = lane >> 4;
    const int K = g.K, nt = K / BK;
    unsigned voffA[2], voffB[2];
#pragma unroll
    for (int i = 0; i < 2; ++i) { int R, C; stage_rc(tid * 16 + i * 8192, R, C); const int Rb = Epi::PERM ? ((R & ~31) + perm32(R & 31)) : R;
        voffA[i] = (unsigned)(R * K + C) * 2u; voffB[i] = (unsigned)(Rb * K + C) * 2u; }
    const size_t kstep = (size_t)(BK * 2);
    const size_t hstep = (size_t)HALF * K * 2;
    const size_t tstep = 2 * hstep;
    const unsigned ldsw = (unsigned)wid * 1024u;
    const int aoff = lds_byte(wr * 64 + fr, fq * 8), boff = lds_byte(wc * 32 + fr, fq * 8);
#define PG8_SA(b, h) (((b) * 2 + (h)) * HTB)
#define PG8_SB(b, h) ((4 + (b) * 2 + (h)) * HTB)
#define PG8_STAGE(bufoff, gbase, voff) do { _Pragma("unroll") for (int _i = 0; _i < 2; ++_i) \
        __builtin_amdgcn_global_load_lds((const unsigned*)((const char*)(gbase) + (voff)[_i]), (PG8_LAS unsigned*)(lds + (bufoff) + ldsw + _i * 8192), 16, 0, 0); } while (0)
#define PG8_LDA(dst, b, h) do { _Pragma("unroll") for (int m = 0; m < 4; ++m) _Pragma("unroll") for (int k = 0; k < 2; ++k) dst[m][k] = *(const PG8_LAS bf16x8*)(lds + PG8_SA(b, h) + aoff + m * 2048 + k * 1024); } while (0)
#define PG8_LDB(dst, b, h) do { _Pragma("unroll") for (int n = 0; n < 2; ++n) _Pragma("unroll") for (int k = 0; k < 2; ++k) dst[n][k] = *(const PG8_LAS bf16x8*)(lds + PG8_SB(b, h) + boff + n * 2048 + k * 1024); } while (0)
#define PG8_MMA(ai, bj, At, Bt) do { __builtin_amdgcn_s_setprio(1); _Pragma("unroll") for (int m = 0; m < 4; ++m) _Pragma("unroll") for (int n = 0; n < 2; ++n) _Pragma("unroll") for (int k = 0; k < 2; ++k) \
        acc[ai][bj][m][n] = __builtin_amdgcn_mfma_f32_16x16x32_bf16(Bt[n][k], At[m][k], acc[ai][bj][m][n], 0, 0, 0); __builtin_amdgcn_s_setprio(0); } while (0)
#define PG8_WAIT_V(n) asm volatile("s_waitcnt vmcnt(" #n ")" ::: "memory")
#define PG8_WAIT_L(n) asm volatile("s_waitcnt lgkmcnt(" #n ")" ::: "memory")
#define PG8_BAR __builtin_amdgcn_s_barrier()
#define PG8_SCHED __builtin_amdgcn_sched_barrier(0)
    Unit cur, nxt; int ui = 0;
    if (!S.next(0, cur)) return;
    f32x4 acc[2][2][4][2];
#pragma unroll
    for (int a = 0; a < 2; ++a)
#pragma unroll
        for (int b = 0; b < 2; ++b)
#pragma unroll
            for (int m = 0; m < 4; ++m)
#pragma unroll
                for (int n = 0; n < 2; ++n) acc[a][b][m][n] = (f32x4){0.f, 0.f, 0.f, 0.f};
    bf16x8 At[4][2], B0[2][2], B1[2][2];
    const char* cA = (const char*)g.A + (size_t)cur.pm * tstep; const char* cB = (const char*)g.Bt + (size_t)cur.pn * tstep;
    S.a_ready(cur);
    if constexpr (SP2) {
        PG8_STAGE(PG8_SB(0, 0), cB, voffB); PG8_STAGE(PG8_SB(0, 1), cB + hstep, voffB); PG8_STAGE(PG8_SA(0, 0), cA, voffA); PG8_STAGE(PG8_SA(0, 1), cA + hstep, voffA);
        if (wr == 1) PG8_BAR;
        PG8_WAIT_V(2); PG8_BAR;
        PG8_STAGE(PG8_SB(1, 0), cB + kstep, voffB); PG8_STAGE(PG8_SA(1, 0), cA + kstep, voffA); PG8_STAGE(PG8_SB(1, 1), cB + hstep + kstep, voffB);
        PG8_WAIT_V(6); PG8_BAR;
    } else {
        PG8_STAGE(PG8_SB(0, 0), cB, voffB); PG8_STAGE(PG8_SA(0, 0), cA, voffA); PG8_STAGE(PG8_SB(0, 1), cB + hstep, voffB); PG8_STAGE(PG8_SA(0, 1), cA + hstep, voffA);
        if (wr == 1) PG8_BAR;
        PG8_WAIT_V(4); PG8_BAR;
        PG8_STAGE(PG8_SB(1, 0), cB + kstep, voffB); PG8_STAGE(PG8_SA(1, 0), cA + kstep, voffA); PG8_STAGE(PG8_SB(1, 1), cB + hstep + kstep, voffB);
        PG8_WAIT_V(6); PG8_BAR;
    }
    for (;;) {
        const bool has_next = S.next(ui + 1, nxt);
        const char* nA = has_next ? (const char*)g.A + (size_t)nxt.pm * tstep : cA; const char* nB = has_next ? (const char*)g.Bt + (size_t)nxt.pn * tstep : cB;
        for (int t = 0; t < nt; t += 2) {
            const bool last = (t == nt - 2);
            const char* a1 = cA + (size_t)(t + 1) * kstep;
            const char* a2 = last ? nA : cA + (size_t)(t + 2) * kstep; const char* b2 = last ? nB : cB + (size_t)(t + 2) * kstep;
            const char* a3 = a2 + kstep; const char* b3 = b2 + kstep;
            if (last && has_next) S.a_ready(nxt);
            if constexpr (SP2) {
            PG8_LDB(B0, 0, 0); PG8_LDB(B1, 0, 1); PG8_SCHED; PG8_LDA(At, 0, 0); PG8_STAGE(PG8_SA(1, 1), a1 + hstep, voffA);
            PG8_WAIT_V(8); PG8_WAIT_L(0); PG8_BAR; PG8_MMA(0, 0, At, B0); PG8_MMA(0, 1, At, B1); PG8_BAR; PG8_SCHED;
            PG8_LDA(At, 0, 1); PG8_STAGE(PG8_SB(0, 0), b2, voffB); PG8_STAGE(PG8_SB(0, 1), b2 + hstep, voffB); PG8_STAGE(PG8_SA(0, 0), a2, voffA);
            PG8_WAIT_V(8); PG8_WAIT_L(0); PG8_BAR; PG8_MMA(1, 0, At, B0); PG8_MMA(1, 1, At, B1); PG8_BAR; PG8_SCHED;
            PG8_LDB(B0, 1, 0); PG8_LDB(B1, 1, 1); PG8_SCHED; PG8_LDA(At, 1, 0); PG8_STAGE(PG8_SA(0, 1), a2 + hstep, voffA);
            PG8_WAIT_V(8); PG8_WAIT_L(0); PG8_BAR; PG8_MMA(0, 0, At, B0); PG8_MMA(0, 1, At, B1); PG8_BAR; PG8_SCHED;
            PG8_LDA(At, 1, 1); PG8_STAGE(PG8_SB(1, 0), b3, voffB); PG8_STAGE(PG8_SB(1, 1), b3 + hstep, voffB); PG8_STAGE(PG8_SA(1, 0), a3, voffA);
            PG8_WAIT_V(8); PG8_WAIT_L(0); PG8_BAR; PG8_MMA(1, 0, At, B0); PG8_MMA(1, 1, At, B1); PG8_BAR; PG8_SCHED;
            } else {
            PG8_LDB(B0, 0, 0); PG8_SCHED; PG8_LDA(At, 0, 0); PG8_STAGE(PG8_SA(1, 1), a1 + hstep, voffA);
            PG8_WAIT_L(8); PG8_BAR; PG8_WAIT_L(0); PG8_MMA(0, 0, At, B0); PG8_BAR; PG8_SCHED;
            PG8_LDB(B1, 0, 1); PG8_STAGE(PG8_SB(0, 0), b2, voffB);
            PG8_BAR; PG8_WAIT_L(0); PG8_MMA(0, 1, At, B1); PG8_BAR;
            PG8_LDA(At, 0, 1); PG8_STAGE(PG8_SA(0, 0), a2, voffA);
            PG8_BAR; PG8_WAIT_L(0); PG8_MMA(1, 0, At, B0); PG8_BAR; PG8_SCHED;
            PG8_STAGE(PG8_SB(0, 1), b2 + hstep, voffB);
            PG8_WAIT_V(6); PG8_BAR; PG8_MMA(1, 1, At, B1); PG8_BAR;
            PG8_LDB(B0, 1, 0); PG8_SCHED; PG8_LDA(At, 1, 0); PG8_STAGE(PG8_SA(0, 1), a2 + hstep, voffA);
            PG8_WAIT_L(8); PG8_BAR; PG8_WAIT_L(0); PG8_MMA(0, 0, At, B0); PG8_BAR; PG8_SCHED;
            PG8_LDB(B1, 1, 1); PG8_STAGE(PG8_SB(1, 0), b3, voffB);
            PG8_BAR; PG8_WAIT_L(0); PG8_MMA(0, 1, At, B1); PG8_BAR;
            PG8_LDA(At, 1, 1); PG8_STAGE(PG8_SA(1, 0), a3, voffA);
            PG8_BAR; PG8_WAIT_L(0); PG8_MMA(1, 0, At, B0); PG8_BAR; PG8_SCHED;
            PG8_STAGE(PG8_SB(1, 1), b3 + hstep, voffB);
            PG8_WAIT_V(6); PG8_BAR; PG8_MMA(1, 1, At, B1); PG8_BAR;
            }
        }
        if constexpr (ALIGN_EPI) { if (wr == 0) PG8_BAR; }
        if constexpr (!Epi::AFTER_DRAIN) { E(acc, cur, wr, wc, fr, fq); S.done(cur); }
        if (!has_next) break;
#pragma unroll
        for (int a = 0; a < 2; ++a)
#pragma unroll
            for (int b = 0; b < 2; ++b)
#pragma unroll
                for (int m = 0; m < 4; ++m)
#pragma unroll
                    for (int n = 0; n < 2; ++n) acc[a][b][m][n] = (f32x4){0.f, 0.f, 0.f, 0.f};
        cur = nxt; cA = nA; cB = nB; ++ui;
        if constexpr (ALIGN_EPI) { if (wr == 1) PG8_BAR; }
    }
    PG8_WAIT_V(0);
    if constexpr (!ALIGN_EPI) { if (wr == 0) PG8_BAR; }
    PG8_BAR;
    if constexpr (Epi::AFTER_DRAIN) { E.fused(acc, cur, wr, wc, fr, fq, lds, wid, lane); S.done(cur); }
#undef PG8_SA
#undef PG8_SB
#undef PG8_STAGE
#undef PG8_LDA
#undef PG8_LDB
#undef PG8_MMA
#undef PG8_WAIT_V
#undef PG8_WAIT_L
#undef PG8_BAR
#undef PG8_SCHED
}
}

#ifndef MK_N_LAUNCHES
#define MK_N_LAUNCHES 1
#endif
#ifndef PROBE_SEQ
#define PROBE_SEQ 0, 1, 2, 3, 4, 5
#endif
constexpr int NB = 4, SEQ = 4096, DM = 1024, M = NB * SEQ, NIN = 9216;
constexpr int NWAVES = 8, NTHREADS = 512, N_PHASES = 6;
constexpr size_t MiB = 1u << 20;
constexpr size_t WS_CTL = 0, WS_WS = 1 * MiB, WS_PART = 2 * MiB, WS_PART2 = 4 * MiB, WS_WTA = 6 * MiB, WS_WTB = 8 * MiB, WS_WTO = 10 * MiB,
                 WS_WTIN = 12 * MiB, WS_H = 32 * MiB, WS_Q = 64 * MiB, WS_K = 96 * MiB, WS_V = 128 * MiB, WS_ZA = 160 * MiB, WS_UZ = 192 * MiB,
                 WS_GV = 224 * MiB, WS_END = 256 * MiB;
constexpr int RING_BYTES = 131072, LDS_BYTES = 147456, LDSCTL_OFF = RING_BYTES, MISC_OFF = LDSCTL_OFF + 320;
constexpr size_t CTL_ZERO_BYTES = 65536, CW_BAR = 4096, WS_LAM = 65536;
constexpr float QSCALE = 0.125f * 1.4426950408889634f;
constexpr float LOG2E = 1.4426950408889634f;

#define LAS __attribute__((address_space(3)))
typedef unsigned short bf16;
typedef unsigned v4u __attribute__((ext_vector_type(4)));
typedef unsigned v2u __attribute__((ext_vector_type(2)));
typedef float f32x4 __attribute__((ext_vector_type(4)));
typedef float f32x2 __attribute__((ext_vector_type(2)));
typedef float f32x16 __attribute__((ext_vector_type(16)));
typedef short bf16x8 __attribute__((ext_vector_type(8)));
typedef short s16x4 __attribute__((ext_vector_type(4)));
typedef __bf16 bf16x2_t __attribute__((ext_vector_type(2)));

__device__ __forceinline__ unsigned pk2(float lo, float hi) { f32x2 v = {lo, hi}; bf16x2_t b = __builtin_convertvector(v, bf16x2_t); return __builtin_bit_cast(unsigned, b); }
__device__ __forceinline__ float bflo(unsigned u) { return __uint_as_float(u << 16); }
__device__ __forceinline__ float bfhi(unsigned u) { return __uint_as_float(u & 0xffff0000u); }
__device__ __forceinline__ float fast_sigmoid(float x) { return __builtin_amdgcn_rcpf(1.f + __builtin_amdgcn_exp2f(-LOG2E * x)); }
__device__ __forceinline__ float silu_f(float x) { return x * fast_sigmoid(x); }
__device__ __forceinline__ float gelu_tanh_f(float x) { return x * fast_sigmoid(1.5957691216057308f * (x + 0.044715f * x * x * x)); }
__device__ __forceinline__ float wave_sum(float v) {
#pragma unroll
    for (int o = 1; o < 64; o <<= 1) v += __shfl_xor(v, o);
    return v;
}
__device__ __forceinline__ int crow(int r, int hi) { return (r & 3) + 8 * (r >> 2) + 4 * hi; }

struct EpiInProj {
    static constexpr bool PERM = true, AFTER_DRAIN = false;
    bf16 *Q, *K, *V, *ZA, *UZ, *GV, *GA, *GB; float* part;
    template <int ACT> __device__ __forceinline__ void plain(const pg8::f32x4 (&acc)[2][2][4][2], bf16* base, int row0, int col0, int pn, int wc, int fq) const {
#pragma unroll
        for (int ai = 0; ai < 2; ++ai)
#pragma unroll
            for (int m = 0; m < 4; ++m) {
                const int row = row0 + ai * 128 + m * 16; bf16* rowp = base + (size_t)row * DM + col0;
                float s1 = 0.f, s2 = 0.f;
#pragma unroll
                for (int bj = 0; bj < 2; ++bj) {
                    float v[8];
#pragma unroll
                    for (int j = 0; j < 4; ++j) { v[j] = acc[ai][bj][m][0][j]; v[4 + j] = acc[ai][bj][m][1][j]; }
#pragma unroll
                    for (int j = 0; j < 8; ++j) {
                        if (ACT == 1) v[j] *= QSCALE;
                        if (ACT == 2) v[j] = silu_f(v[j]);
                        if (ACT == 3) { v[j] = gelu_tanh_f(v[j]); s1 += v[j]; s2 += v[j] * v[j]; }
                        if (ACT == 4) v[j] = fast_sigmoid(v[j]);
                    }
                    v4u w; w.x = pk2(v[0], v[1]); w.y = pk2(v[2], v[3]); w.z = pk2(v[4], v[5]); w.w = pk2(v[6], v[7]);
                    *(v4u*)(rowp + bj * 128) = w;
                }
                if (ACT == 3) {
                    s1 += __shfl_xor(s1, 16); s1 += __shfl_xor(s1, 32); s2 += __shfl_xor(s2, 16); s2 += __shfl_xor(s2, 32);
                    if (fq == 0) *(f32x2*)(part + ((size_t)row * 16 + (pn - 24) * 4 + wc) * 2) = (f32x2){s1, s2};
                }
            }
    }
    __device__ __forceinline__ void operator()(const pg8::f32x4 (&acc)[2][2][4][2], const pg8::Unit& u, int wr, int wc, int fr, int fq) const {
        const int pn = u.pn, row0 = u.pm * 256 + wr * 64 + fr, cw = wc * 32 + 8 * fq;
        if (pn >= 16 && pn < 24) {
            const int j = pn - 16;
#pragma unroll
            for (int ai = 0; ai < 2; ++ai)
#pragma unroll
                for (int m = 0; m < 4; ++m) {
                    const int row = row0 + ai * 128 + m * 16; float v[8];
#pragma unroll
                    for (int n = 0; n < 2; ++n)
#pragma unroll
                        for (int e = 0; e < 4; ++e) v[4 * n + e] = gelu_tanh_f(acc[ai][0][m][n][e]) * silu_f(acc[ai][1][m][n][e]);
                    v4u w; w.x = pk2(v[0], v[1]); w.y = pk2(v[2], v[3]); w.z = pk2(v[4], v[5]); w.w = pk2(v[6], v[7]);
                    *(v4u*)(UZ + (size_t)row * DM + j * 128 + cw) = w;
                }
            return;
        }
        const int sec = pn >> 2, col0 = (pn & 3) * 256 + cw;
        if (sec == 0) plain<1>(acc, Q, row0, col0, pn, wc, fq);
        else if (sec == 1) plain<0>(acc, K, row0, col0, pn, wc, fq);
        else if (sec == 2) plain<0>(acc, V, row0, col0, pn, wc, fq);
        else if (sec == 3) plain<2>(acc, ZA, row0, col0, pn, wc, fq);
        else if (sec == 6) plain<3>(acc, GV, row0, col0, pn, wc, fq);
        else if (sec == 7) plain<4>(acc, GA, row0, col0, pn, wc, fq);
        else plain<4>(acc, GB, row0, col0, pn, wc, fq);
    }
};
struct EpiMerge1 {
    static constexpr bool PERM = true, AFTER_DRAIN = false;
    const bf16* G; float* T;
    __device__ __forceinline__ void operator()(const pg8::f32x4 (&acc)[2][2][4][2], const pg8::Unit& u, int wr, int wc, int fr, int fq) const {
        const int row0 = u.pm * 256 + wr * 64 + fr, col0 = u.pn * 256 + wc * 32 + 8 * fq;
#pragma unroll
        for (int ai = 0; ai < 2; ++ai)
#pragma unroll
            for (int m = 0; m < 4; ++m)
#pragma unroll
                for (int bj = 0; bj < 2; ++bj) {
                    const size_t off = (size_t)(row0 + ai * 128 + m * 16) * DM + col0 + bj * 128;
                    const v4u g = *(const v4u*)(G + off);
                    f32x4 t0 = acc[ai][bj][m][0], t1 = acc[ai][bj][m][1];
                    t0[0] *= bflo(g.x); t0[1] *= bfhi(g.x); t0[2] *= bflo(g.y); t0[3] *= bfhi(g.y);
                    t1[0] *= bflo(g.z); t1[1] *= bfhi(g.z); t1[2] *= bflo(g.w); t1[3] *= bfhi(g.w);
                    *(f32x4*)(T + off) = t0; *(f32x4*)(T + off + 4) = t1;
                }
    }
};
struct EpiMerge2 {
    static constexpr bool PERM = true, AFTER_DRAIN = false;
    const bf16* G; const float* T; bf16* O;
    __device__ __forceinline__ void operator()(const pg8::f32x4 (&acc)[2][2][4][2], const pg8::Unit& u, int wr, int wc, int fr, int fq) const {
        const int row0 = u.pm * 256 + wr * 64 + fr, col0 = u.pn * 256 + wc * 32 + 8 * fq;
#pragma unroll
        for (int ai = 0; ai < 2; ++ai)
#pragma unroll
            for (int m = 0; m < 4; ++m)
#pragma unroll
                for (int bj = 0; bj < 2; ++bj) {
                    const size_t off = (size_t)(row0 + ai * 128 + m * 16) * DM + col0 + bj * 128;
                    const v4u g = *(const v4u*)(G + off);
                    f32x4 t0 = *(const f32x4*)(T + off), t1 = *(const f32x4*)(T + off + 4);
                    const f32x4 a0 = acc[ai][bj][m][0], a1 = acc[ai][bj][m][1];
                    t0[0] += a0[0] * bflo(g.x); t0[1] += a0[1] * bfhi(g.x); t0[2] += a0[2] * bflo(g.y); t0[3] += a0[3] * bfhi(g.y);
                    t1[0] += a1[0] * bflo(g.z); t1[1] += a1[1] * bfhi(g.z); t1[2] += a1[2] * bflo(g.w); t1[3] += a1[3] * bfhi(g.w);
                    v4u w; w.x = pk2(t0[0], t0[1]); w.y = pk2(t0[2], t0[3]); w.z = pk2(t1[0], t1[1]); w.w = pk2(t1[2], t1[3]);
                    *(v4u*)(O + off) = w;
                }
    }
};
struct EpiOut {
    static constexpr bool PERM = false, AFTER_DRAIN = false;
    const float* X; float* O; float* part2;
    __device__ __forceinline__ void operator()(const pg8::f32x4 (&acc)[2][2][4][2], const pg8::Unit& u, int wr, int wc, int fr, int fq) const {
        const int row0 = u.pm * 256 + wr * 64 + fr, col0 = u.pn * 256 + wc * 32 + 4 * fq;
#pragma unroll
        for (int ai = 0; ai < 2; ++ai)
#pragma unroll
            for (int m = 0; m < 4; ++m) {
                const int row = row0 + ai * 128 + m * 16; float s2 = 0.f;
#pragma unroll
                for (int bj = 0; bj < 2; ++bj)
#pragma unroll
                    for (int n = 0; n < 2; ++n) {
                        const size_t off = (size_t)row * DM + col0 + bj * 128 + n * 16;
                        const f32x4 v = *(const f32x4*)(X + off) + acc[ai][bj][m][n];
                        s2 += (v[0] * v[0] + v[1] * v[1]) + (v[2] * v[2] + v[3] * v[3]);
                        *(f32x4*)(O + off) = v;
                    }
                s2 += __shfl_xor(s2, 16); s2 += __shfl_xor(s2, 32);
                if (fq == 0) part2[(size_t)row * 16 + u.pn * 4 + wc] = s2;
            }
    }
};

__device__ __forceinline__ int win_src_col(int n) {
    const int pn = n >> 8, cc = n & 255;
    if (pn < 16) return n;
    if (pn < 24) { const int j = pn - 16; return cc < 128 ? 4096 + 128 * j + cc : 6144 + 128 * j + (cc - 128); }
    if (pn < 28) return 5120 + (n - 24 * 256);
    return 7168 + (n - 28 * 256);
}
__device__ __forceinline__ void p0_transpose_item(const float* W, int K, int N, bf16* WT, bool permute, LAS float* scr, int item, int lane) {
    const int nblk = N / 32, kb = item / nblk, nb = item % nblk, k0 = 64 * kb, n0 = 32 * nb;
    const int n0s = permute ? win_src_col(n0) : n0;
#pragma unroll 8
    for (int i = 0; i < 32; ++i) { const int kk = 2 * i + (lane >> 5); scr[kk * 33 + (lane & 31)] = W[(size_t)(k0 + kk) * N + n0s + (lane & 31)]; }
    asm volatile("s_waitcnt lgkmcnt(0)" ::: "memory");
    const int c = lane & 7;
#pragma unroll
    for (int j = 0; j < 4; ++j) { const int n = (lane >> 3) + 8 * j; const LAS float* s = scr + (8 * c) * 33 + n;
        v4u o; o.x = pk2(s[0 * 33], s[1 * 33]); o.y = pk2(s[2 * 33], s[3 * 33]); o.z = pk2(s[4 * 33], s[5 * 33]); o.w = pk2(s[6 * 33], s[7 * 33]);
        *(v4u*)(WT + (size_t)(n0 + n) * K + k0 + 8 * c) = o; }
    asm volatile("s_waitcnt lgkmcnt(0)" ::: "memory");
}

struct Args { const float* in[16]; float* out; unsigned char* ws; int ph_lo, ph_hi; };

__device__ __forceinline__ void p0_prologue(const Args& a, LAS unsigned char* lds, int vcu, int G, int wave, int lane) {
    unsigned char* ws = a.ws;
    LAS float* scr = (LAS float*)(lds + wave * 16384);
    const int gw = vcu * NWAVES + wave, NGW = G * NWAVES;
    constexpr int I_IN = (DM / 64) * (NIN / 32), I_SQ = (DM / 64) * (DM / 32);
    constexpr int NITEMS = I_IN + 3 * I_SQ;
    for (int it = gw; it < NITEMS; it += NGW) {
        int r = it;
        if (r < I_IN) { p0_transpose_item(a.in[2], DM, NIN, (bf16*)(ws + WS_WTIN), true, scr, r, lane); continue; } r -= I_IN;
        if (r < I_SQ) { p0_transpose_item(a.in[12], DM, DM, (bf16*)(ws + WS_WTA), false, scr, r, lane); continue; } r -= I_SQ;
        if (r < I_SQ) { p0_transpose_item(a.in[13], DM, DM, (bf16*)(ws + WS_WTB), false, scr, r, lane); continue; } r -= I_SQ;
        p0_transpose_item(a.in[14], DM, DM, (bf16*)(ws + WS_WTO), false, scr, r, lane);
    }
    const float* x = a.in[0]; const float* ng = a.in[1]; bf16* H = (bf16*)(ws + WS_H);
    f32x4 g4[4];
#pragma unroll
    for (int j = 0; j < 4; ++j) g4[j] = ((const f32x4*)ng)[64 * j + lane];
    for (int m = gw; m < M; m += NGW) {
        const f32x4* xr = (const f32x4*)(x + (size_t)m * DM) + lane; f32x4 v[4]; float s = 0.f;
#pragma unroll
        for (int j = 0; j < 4; ++j) { v[j] = xr[64 * j]; s += (v[j][0] * v[j][0] + v[j][1] * v[j][1]) + (v[j][2] * v[j][2] + v[j][3] * v[j][3]); }
        const float rstd = 1.0f / sqrtf(wave_sum(s) * (1.f / DM) + 1e-6f);
        v2u* o8 = (v2u*)(H + (size_t)m * DM) + lane;
#pragma unroll
        for (int j = 0; j < 4; ++j) { const f32x4 y = v[j] * rstd * g4[j]; o8[64 * j] = (v2u){pk2(y[0], y[1]), pk2(y[2], y[3])}; }
    }
    const float* w_s = a.in[10]; bf16* WSb = (bf16*)(ws + WS_WS);
    for (int i = gw * 64 + lane; i < 8 * 128 * 128; i += NGW * 64) { const int t = (i >> 7) & 127, s = i & 127; const float v = (s <= t) ? w_s[i] : 0.f; WSb[i] = (bf16)(pk2(v, 0.f) & 0xffffu); }
    if (gw == 0) {
        const float sa = wave_sum(a.in[3][lane] * a.in[4][lane]), sb = wave_sum(a.in[5][lane] * a.in[6][lane]);
        if (lane == 0) ((float*)(ws + WS_LAM))[0] = expf(sa) - expf(sb) + 0.2f;
    }
}

namespace att {
constexpr int L_K = 0, L_V = 16384, L_WSF = 49152, L_ST = 53248, L_END = L_ST + 65536;
__device__ __forceinline__ s16x4 vtr(const LAS unsigned char* p) { typedef short v4i16_t __attribute__((ext_vector_type(4))); return __builtin_bit_cast(s16x4, __builtin_amdgcn_ds_read_tr16_b64_v4i16((LAS v4i16_t*)p)); }
#define MFMA32(a, b, c) __builtin_amdgcn_mfma_f32_32x32x16_bf16((a), (b), (c), 0, 0, 0)

#define SBAR() __builtin_amdgcn_sched_barrier(0)
#define CINIT16(P, S, C) asm volatile( \
    "v_mov_b32 %0, %17\n\tv_add_f32 %1, %16, %17\n\tv_fmamk_f32 %2, %16, 0x40000000, %17\n\tv_fmamk_f32 %3, %16, 0x40400000, %17\n\t" \
    "v_fmamk_f32 %4, %16, 0x41000000, %17\n\tv_fmamk_f32 %5, %16, 0x41100000, %17\n\tv_fmamk_f32 %6, %16, 0x41200000, %17\n\tv_fmamk_f32 %7, %16, 0x41300000, %17\n\t" \
    "v_fmamk_f32 %8, %16, 0x41800000, %17\n\tv_fmamk_f32 %9, %16, 0x41880000, %17\n\tv_fmamk_f32 %10, %16, 0x41900000, %17\n\tv_fmamk_f32 %11, %16, 0x41980000, %17\n\t" \
    "v_fmamk_f32 %12, %16, 0x41c00000, %17\n\tv_fmamk_f32 %13, %16, 0x41c80000, %17\n\tv_fmamk_f32 %14, %16, 0x41d00000, %17\n\tv_fmamk_f32 %15, %16, 0x41d80000, %17\n\ts_nop 1" \
    : "=&v"(P[0]), "=&v"(P[1]), "=&v"(P[2]), "=&v"(P[3]), "=&v"(P[4]), "=&v"(P[5]), "=&v"(P[6]), "=&v"(P[7]), \
      "=&v"(P[8]), "=&v"(P[9]), "=&v"(P[10]), "=&v"(P[11]), "=&v"(P[12]), "=&v"(P[13]), "=&v"(P[14]), "=&v"(P[15]) \
    : "v"(S), "v"(C))
__device__ __forceinline__ void glds16(const void* gsrc, unsigned lds_dst) { unsigned keep;
    asm volatile("s_mov_b32 %0, m0\n\ts_mov_b32 m0, %2\n\ts_nop 0\n\tglobal_load_lds_dwordx4 %1, off\n\ts_mov_b32 m0, %0" : "=&s"(keep) : "v"(gsrc), "s"(lds_dst) : "memory"); }
#define MX3(a, b, c) __builtin_fmaxf(__builtin_fmaxf((a), (b)), (c))
__device__ __forceinline__ void sweep(f32x16 (&o)[4], const bf16* Qm, const bf16* Km, const bf16* Vh, int q0, int NT, float sl, LAS unsigned char* lds, int tid, int wid, int lane, int r32, int hi) {
    const int q0w = q0 + wid * 32, qrow = q0w + r32;
    bf16x8 qr[4];
#pragma unroll
    for (int d0 = 0; d0 < 4; ++d0) qr[d0] = *(const bf16x8*)(Qm + (size_t)qrow * DM + d0 * 16 + hi * 8);
#pragma unroll
    for (int e = 0; e < 4; ++e)
#pragma unroll
        for (int i = 0; i < 16; ++i) o[e][i] = 0.f;
    float mhat = 0.f, lsum = 0.f;
    LAS float* wsf = (LAS float*)(lds + L_WSF) + wid * 64;
    const unsigned koff = (unsigned)(lane * DM + wid * 8);
    const unsigned voff0 = (unsigned)((16 * (wid & 3) + (lane >> 2)) * DM + (wid >> 2) * 32 + (lane & 3) * 8), voff1 = voff0 + 64;
#define ATT_STAGE(tt, bb) do { const bf16* Kt_ = Km + (size_t)(tt) * 64 * DM; const bf16* Vt_ = Vh + (size_t)(tt) * 64 * DM; \
        glds16(Kt_ + koff, ldsb + L_K + (bb) * 8192 + wid * 1024); glds16(Vt_ + voff0, ldsb + L_V + (bb) * 16384 + wid * 1024); glds16(Vt_ + voff1, ldsb + L_V + (bb) * 16384 + 8192 + wid * 1024); } while (0)
    const unsigned ldsb = (unsigned)(uintptr_t)lds;
    ATT_STAGE(0, 0);
    asm volatile("s_waitcnt vmcnt(0)" ::: "memory");
    __syncthreads();
    const int voff = ((lane >> 4) & 1) * 32 + (lane & 3) * 8 + (4 * hi + ((lane & 15) >> 2)) * 64;
    for (int t = 0; t < NT; ++t) {
        const int buf = t & 1;
        if (t + 1 < NT) ATT_STAGE(t + 1, buf ^ 1);
        if (64 * t <= q0w + 31) {
            const LAS unsigned char* Kb = lds + L_K + buf * 8192 + hi * 1024 + r32 * 16;
            const LAS unsigned char* Vb = lds + L_V + buf * 16384 + voff;
            bf16x8 kf[8];
#pragma unroll
            for (int d0 = 0; d0 < 4; ++d0) { kf[2 * d0] = *(const LAS bf16x8*)(Kb + d0 * 2048); kf[2 * d0 + 1] = *(const LAS bf16x8*)(Kb + d0 * 2048 + 512); }
            const float cb0 = sl * (float)(64 * t + 4 * hi - q0w) - mhat, cb1 = cb0 + 32.f * sl;
            f32x16 p0, p1;
            CINIT16(p0, sl, cb0); CINIT16(p1, sl, cb1);
            SBAR();
#pragma unroll
            for (int d0 = 0; d0 < 4; ++d0) { p0 = MFMA32(kf[2 * d0], qr[d0], p0); p1 = MFMA32(kf[2 * d0 + 1], qr[d0], p1); }
            s16x4 vl[2][4], vh[2][4];
#pragma unroll
            for (int e = 0; e < 2; ++e)
#pragma unroll
                for (int s = 0; s < 4; ++s) { vl[e][s] = vtr(Vb + e * 4096 + s * 1024); vh[e][s] = vtr(Vb + e * 4096 + s * 1024 + 512); }
            SBAR();
            if (64 * t + 63 > q0w) {
                const int lim = qrow - 64 * t - 4 * hi;
#pragma unroll
                for (int i = 0; i < 16; ++i) { const int n_i = (i & 3) + 8 * (i >> 2); if (n_i > lim) p0[i] = -INFINITY; if (n_i + 32 > lim) p1[i] = -INFINITY; }
            }
            float ra = MX3(p0[0], p0[1], p1[0]), rb = MX3(p0[2], p0[3], p1[1]); ra = MX3(ra, p1[2], p1[3]);
#pragma unroll
            for (int i = 4; i < 16; i += 4) { ra = MX3(ra, p0[i], p0[i + 1]); rb = MX3(rb, p0[i + 2], p0[i + 3]); ra = MX3(ra, p1[i], p1[i + 1]); rb = MX3(rb, p1[i + 2], p1[i + 3]); }
            float rm = __builtin_fmaxf(ra, rb);
            { auto rr = __builtin_amdgcn_permlane32_swap(__float_as_uint(rm), __float_as_uint(rm), false, false); rm = __builtin_fmaxf(__uint_as_float(rr[0]), __uint_as_float(rr[1])); }
            if (t == 0 || __any(rm > 8.f)) {
                const float dl = (t == 0) ? rm : __builtin_fmaxf(rm, 0.f); mhat += dl;
#pragma unroll
                for (int i = 0; i < 16; ++i) { p0[i] -= dl; p1[i] -= dl; }
                if (t != 0) {
                    const float f = __builtin_amdgcn_exp2f(-dl); lsum *= f;
                    if (hi == 0) wsf[r32] = f;
                    asm volatile("s_waitcnt lgkmcnt(0)" ::: "memory");
#pragma unroll
                    for (int i = 0; i < 16; ++i) { const float fi = wsf[crow(i, hi)];
#pragma unroll
                        for (int e = 0; e < 4; ++e) o[e][i] *= fi; }
                }
            }
            float ls0 = 0.f, ls1 = 0.f;
#pragma unroll
            for (int i = 0; i < 16; ++i) { p0[i] = __builtin_amdgcn_exp2f(p0[i]); p1[i] = __builtin_amdgcn_exp2f(p1[i]); ls0 += p0[i]; ls1 += p1[i]; }
            lsum += ls0 + ls1;
            bf16x8 pa[4];
            { v4u w;
              w.x = pk2(p0[0], p0[1]); w.y = pk2(p0[2], p0[3]); w.z = pk2(p0[4], p0[5]); w.w = pk2(p0[6], p0[7]); pa[0] = __builtin_bit_cast(bf16x8, w);
              w.x = pk2(p0[8], p0[9]); w.y = pk2(p0[10], p0[11]); w.z = pk2(p0[12], p0[13]); w.w = pk2(p0[14], p0[15]); pa[1] = __builtin_bit_cast(bf16x8, w);
              w.x = pk2(p1[0], p1[1]); w.y = pk2(p1[2], p1[3]); w.z = pk2(p1[4], p1[5]); w.w = pk2(p1[6], p1[7]); pa[2] = __builtin_bit_cast(bf16x8, w);
              w.x = pk2(p1[8], p1[9]); w.y = pk2(p1[10], p1[11]); w.z = pk2(p1[12], p1[13]); w.w = pk2(p1[14], p1[15]); pa[3] = __builtin_bit_cast(bf16x8, w); }
            SBAR();
#define PV_E(E, X) do { _Pragma("unroll") for (int s = 0; s < 4; ++s) o[E] = MFMA32(pa[s], __builtin_shufflevector(vl[X][s], vh[X][s], 0, 1, 2, 3, 4, 5, 6, 7), o[E]); } while (0)
#define RD_E(E, X) do { _Pragma("unroll") for (int s = 0; s < 4; ++s) { vl[X][s] = vtr(Vb + (E) * 4096 + s * 1024); vh[X][s] = vtr(Vb + (E) * 4096 + s * 1024 + 512); } } while (0)
            PV_E(0, 0); SBAR();
            RD_E(2, 0); PV_E(1, 1); SBAR();
            RD_E(3, 1); PV_E(2, 0); SBAR();
            PV_E(3, 1);
#undef PV_E
#undef RD_E
        }
        asm volatile("s_waitcnt vmcnt(0)" ::: "memory");
        __syncthreads();
    }
    { auto rr = __builtin_amdgcn_permlane32_swap(__float_as_uint(lsum), __float_as_uint(lsum), false, false); lsum = __uint_as_float(rr[0]) + __uint_as_float(rr[1]); }
    if (hi == 0) wsf[32 + r32] = lsum;
    asm volatile("s_waitcnt lgkmcnt(0)" ::: "memory");
#pragma unroll
    for (int i = 0; i < 16; ++i) { const float rl = __builtin_amdgcn_rcpf(wsf[32 + crow(i, hi)]);
#pragma unroll
        for (int e = 0; e < 4; ++e) o[e][i] *= rl; }
    asm volatile("s_waitcnt lgkmcnt(0)" ::: "memory");
}

__device__ __forceinline__ void unit(int b, int h, int qb, bf16* Q, const bf16* K, const bf16* V, const bf16* ZA, const float* subg, float lam, LAS unsigned char* lds, bool dry = false) {
    const int tid = threadIdx.x, lane = tid & 63, r32 = lane & 31, hi = lane >> 5, wid = __builtin_amdgcn_readfirstlane(tid >> 6);
    const size_t rowbase = (size_t)b * SEQ; const int q0 = qb * 256, NT = 4 * (qb + 1);
    const float sl = exp2f(-(float)(h + 1)) * LOG2E;
    f32x16 o[4];
    LAS unsigned* stw = (LAS unsigned*)(lds + L_ST) + wid * 2048 + lane;
    sweep(o, Q + rowbase * DM + h * 128, K + rowbase * DM + h * 128, V + rowbase * DM + h * 128, q0, NT, sl, lds, tid, wid, lane, r32, hi);
#pragma unroll
    for (int e = 0; e < 4; ++e)
#pragma unroll
        for (int i = 0; i < 8; ++i) stw[(e * 8 + i) * 64] = pk2(o[e][2 * i], o[e][2 * i + 1]);
    sweep(o, Q + rowbase * DM + h * 128 + 64, K + rowbase * DM + h * 128 + 64, V + rowbase * DM + h * 128, q0, NT, sl, lds, tid, wid, lane, r32, hi);
    float ssq[16];
#pragma unroll
    for (int e = 0; e < 4; ++e)
#pragma unroll
        for (int i = 0; i < 8; ++i) { const unsigned w = stw[(e * 8 + i) * 64];
            o[e][2 * i] = bflo(w) - lam * o[e][2 * i]; o[e][2 * i + 1] = bfhi(w) - lam * o[e][2 * i + 1]; }
#pragma unroll
    for (int i = 0; i < 16; ++i) { float s = 0.f;
#pragma unroll
        for (int e = 0; e < 4; ++e) s += o[e][i] * o[e][i];
#pragma unroll
        for (int x = 1; x < 32; x <<= 1) s += __shfl_xor(s, x);
        ssq[i] = 0.8f / sqrtf(s * (1.f / 128.f) + 1e-5f); }
    asm volatile("s_waitcnt lgkmcnt(0)" ::: "memory");
    LAS bf16* stg = (LAS bf16*)(lds + L_ST) + wid * 4096;
#pragma unroll
    for (int e = 0; e < 4; ++e) { const float gs = subg[32 * e + r32];
#pragma unroll
        for (int i = 0; i < 16; ++i) stg[crow(i, hi) * 128 + 32 * e + r32] = (bf16)(pk2(o[e][i] * ssq[i] * gs, 0.f) & 0xffffu); }
    asm volatile("s_waitcnt lgkmcnt(0)" ::: "memory");
    bf16* Y = Q;
#pragma unroll
    for (int it = 0; it < 8; ++it) {
        const int row = it * 4 + (lane >> 4), ch = lane & 15;
        const size_t off = (rowbase + q0 + wid * 32 + row) * DM + h * 128 + ch * 8;
        const v4u yv = *(const LAS v4u*)(stg + row * 128 + ch * 8), zv = *(const v4u*)(ZA + off);
        v4u w;
        w.x = pk2(bflo(yv.x) * bflo(zv.x), bfhi(yv.x) * bfhi(zv.x)); w.y = pk2(bflo(yv.y) * bflo(zv.y), bfhi(yv.y) * bfhi(zv.y));
        w.z = pk2(bflo(yv.z) * bflo(zv.z), bfhi(yv.z) * bfhi(zv.z)); w.w = pk2(bflo(yv.w) * bflo(zv.w), bfhi(yv.w) * bfhi(zv.w));
        if (!dry) *(v4u*)(Y + off) = w;
    }
    asm volatile("s_waitcnt lgkmcnt(0)" ::: "memory");
}
}

namespace gm {
constexpr int L_VN = 0, L_ST = 32768;
__device__ __forceinline__ void unit(int chunk, int g, bf16* UZ, const bf16* GV, const float* part, const bf16* WSb, const float* lng, const float* lnb, const float* b_s, LAS unsigned char* lds, bool dry = false) {
    const int tid = threadIdx.x, lane = tid & 63, r32 = lane & 31, hi = lane >> 5, wid = __builtin_amdgcn_readfirstlane(tid >> 6);
    const size_t row0 = (size_t)chunk * 128;
    LAS float* stt = (LAS float*)(lds + L_ST);
    if (tid < 128) {
        const float* p = part + (row0 + tid) * 32; float s1 = 0.f, s2 = 0.f;
#pragma unroll
        for (int j = 0; j < 16; ++j) { s1 += p[2 * j]; s2 += p[2 * j + 1]; }
        const float mu = s1 * (1.f / 1024.f), var = fmaxf(s2 * (1.f / 1024.f) - mu * mu, 0.f);
        stt[2 * tid] = mu; stt[2 * tid + 1] = 1.0f / sqrtf(var + 1e-6f);
    }
    __syncthreads();
#pragma unroll
    for (int it = 0; it < 4; ++it) {
        const int idx = tid + 512 * it, s = idx >> 4, c16 = idx & 15;
        const v4u raw = *(const v4u*)(GV + (row0 + s) * DM + g * 128 + c16 * 8);
        const float mu = stt[2 * s], rs = stt[2 * s + 1];
        const f32x4 ga = *(const f32x4*)(lng + g * 128 + c16 * 8), gb = *(const f32x4*)(lng + g * 128 + c16 * 8 + 4);
        const f32x4 ba = *(const f32x4*)(lnb + g * 128 + c16 * 8), bb = *(const f32x4*)(lnb + g * 128 + c16 * 8 + 4);
        float v[8] = {bflo(raw.x), bfhi(raw.x), bflo(raw.y), bfhi(raw.y), bflo(raw.z), bfhi(raw.z), bflo(raw.w), bfhi(raw.w)};
#pragma unroll
        for (int j = 0; j < 4; ++j) { v[j] = (v[j] - mu) * rs * ga[j] + ba[j]; v[4 + j] = (v[4 + j] - mu) * rs * gb[j] + bb[j]; }
        v4u w; w.x = pk2(v[0], v[1]); w.y = pk2(v[2], v[3]); w.z = pk2(v[4], v[5]); w.w = pk2(v[6], v[7]);
        *(LAS v4u*)(lds + L_VN + (s >> 6) * 16384 + (c16 >> 2) * 4096 + (s & 63) * 64 + (c16 & 3) * 16) = w;
    }
    __syncthreads();
    const int tb = wid >> 1, db0 = 2 * (wid & 1);
    f32x16 acc[2];
#pragma unroll
    for (int i = 0; i < 16; ++i) { acc[0][i] = 0.f; acc[1][i] = 0.f; }
    const bf16* wrow = WSb + ((size_t)g * 128 + tb * 32 + r32) * 128;
    const int voff = ((lane >> 4) & 1) * 32 + (lane & 3) * 8 + (4 * hi + ((lane & 15) >> 2)) * 64;
#pragma unroll
    for (int ks = 0; ks < 8; ++ks) {
        if (ks * 16 > tb * 32 + 31) continue;
        const v2u a_lo = *(const v2u*)(wrow + 16 * ks + 4 * hi), a_hi = *(const v2u*)(wrow + 16 * ks + 8 + 4 * hi);
        const v4u aw = {a_lo.x, a_lo.y, a_hi.x, a_hi.y}; const bf16x8 af = __builtin_bit_cast(bf16x8, aw);
        const LAS unsigned char* Vb = lds + L_VN + (ks >> 2) * 16384 + (ks & 3) * 1024 + voff;
#pragma unroll
        for (int d = 0; d < 2; ++d) {
            const s16x4 lo = att::vtr(Vb + (db0 + d) * 4096), hh = att::vtr(Vb + (db0 + d) * 4096 + 512);
            const bf16x8 vf = __builtin_shufflevector(lo, hh, 0, 1, 2, 3, 4, 5, 6, 7);
            acc[d] = MFMA32(af, vf, acc[d]);
        }
    }
#pragma unroll
    for (int i = 0; i < 16; ++i) {
        const int t = tb * 32 + crow(i, hi); const float bs = b_s[g * 128 + t];
#pragma unroll
        for (int d = 0; d < 2; ++d) {
            const size_t off = (row0 + t) * DM + g * 128 + (db0 + d) * 32 + r32;
            const float uz = bflo((unsigned)UZ[off]);
            const float y = uz * (acc[d][i] + bs);
            if (!dry) UZ[off] = (bf16)(pk2(y, 0.f) & 0xffffu);
        }
    }
    __syncthreads();
}
}

#define XB_TMO      128
#define XB_XCNT(j)  (256  + 64 * (j))
#define XB_XSUB(j)  (1280 + 64 * (j))
#define XB_XGEN(j)  (2304 + 64 * (j))
#define XB_TOP      3328
#define XB_TOPGEN   3392
#define XCD_BAR_WORDS 3456
#define XB_SPIN_CAP (1u << 18)

__device__ __forceinline__ unsigned xb_ld(unsigned* p)              { return __hip_atomic_load(p, __ATOMIC_RELAXED, __HIP_MEMORY_SCOPE_AGENT); }
__device__ __forceinline__ unsigned xb_add(unsigned* p, unsigned v) { return __hip_atomic_fetch_add(p, v, __ATOMIC_RELAXED, __HIP_MEMORY_SCOPE_AGENT); }
__device__ __forceinline__ unsigned xb_xcc_id() { return (unsigned)__builtin_amdgcn_s_getreg((3 << 11) | 20) & 0xFu; }
#define XB_SPIN(cond, bar) do { unsigned _sp = 0; while (cond) { __builtin_amdgcn_s_sleep(1); \
    if ((++_sp & 255u) == 0u) { if (xb_ld(&(bar)[XB_TMO])) break; if (_sp > XB_SPIN_CAP) { atomicAdd(&(bar)[XB_TMO], 1u); break; } } } } while (0)

struct XcdBarrier {
    unsigned* bar; unsigned x;
    volatile LAS unsigned* st;
};

__device__ __forceinline__ XcdBarrier xcd_barrier_post(unsigned* bar, volatile LAS unsigned* st) {
    XcdBarrier b; b.bar = bar; b.x = xb_xcc_id(); b.st = st;
    if (threadIdx.x == 0) (void)xb_add(&bar[XB_XCNT(b.x)], 1u);
    return b;
}
__device__ __forceinline__ void xcd_barrier_complete(unsigned* bar, unsigned x, unsigned& nloc, unsigned& nx) {
    const unsigned G = gridDim.x * gridDim.y * gridDim.z;
    unsigned sum, cnt, mine, sp = 0u;
    for (;;) {
        sum = 0u; cnt = 0u; mine = 0u;
#pragma unroll
        for (unsigned j = 0; j < 16; ++j) { const unsigned c = xb_ld(&bar[XB_XCNT(j)]); sum += c; cnt += (c > 0u) ? 1u : 0u; mine = (j == x) ? c : mine; }
        if (sum == G) break;
        __builtin_amdgcn_s_sleep(1);
        if ((++sp & 255u) == 0u) { if (xb_ld(&bar[XB_TMO])) break; if (sp > XB_SPIN_CAP) { atomicAdd(&bar[XB_TMO], 1u); break; } }
    }
    nloc = mine > 0u ? mine : 1u; nx = cnt > 0u ? cnt : 1u;
}

__device__ __forceinline__ void xcd_barrier(const XcdBarrier& b) {
    asm volatile("s_waitcnt vmcnt(0)" ::: "memory");
    __syncthreads();
    if (threadIdx.x == 0) {
        unsigned* bar = b.bar;
        __builtin_amdgcn_s_waitcnt(0);
        unsigned nloc = b.st[0], nx = b.st[1];
        if (nloc == 0u) { xcd_barrier_complete(bar, b.x, nloc, nx); b.st[0] = nloc; b.st[1] = nx; }
        const unsigned old = xb_add(&bar[XB_XSUB(b.x)], 1u);
        const unsigned gen = old / nloc;
        if (old + 1u == (gen + 1u) * nloc) {
            __builtin_amdgcn_fence(__ATOMIC_RELEASE, "agent");
            asm volatile("s_waitcnt vmcnt(0)" ::: "memory");
            const unsigned og = xb_add(&bar[XB_TOP], 1u);
            const unsigned tg = og / nx;
            if (og + 1u == (tg + 1u) * nx) xb_add(&bar[XB_TOPGEN], 1u);
            else XB_SPIN(xb_ld(&bar[XB_TOPGEN]) == tg, bar);
            __builtin_amdgcn_fence(__ATOMIC_ACQUIRE, "agent");
            xb_add(&bar[XB_XGEN(b.x)], 1u);
            asm volatile("s_waitcnt vmcnt(0)" ::: "memory");
        } else {
            XB_SPIN(xb_ld(&bar[XB_XGEN(b.x)]) == gen, bar);
            __builtin_amdgcn_fence(__ATOMIC_ACQUIRE, "agent");
            asm volatile("s_waitcnt vmcnt(0)" ::: "memory");
        }
    }
    __syncthreads();
}

__global__ void __launch_bounds__(NTHREADS, 2) fwd_kernel(Args args) {
    extern __shared__ __attribute__((aligned(16))) unsigned char lds_raw[];
    LAS unsigned char* lds = (LAS unsigned char*)lds_raw;
    cg::grid_group grid = cg::this_grid();
    const int tid = threadIdx.x, lane = tid & 63, wave = __builtin_amdgcn_readfirstlane(tid >> 6);
    const int G = gridDim.x, bx = blockIdx.x, vcu = (G % 8 == 0) ? (bx % 8) * (G / 8) + bx / 8 : bx;
    unsigned char* ws = args.ws;
    const int lo = args.ph_lo, hi_ph = args.ph_hi;
#define IN(k) (lo <= (k) && (k) < hi_ph)
    for (int u = tid; u < (LDS_BYTES - LDSCTL_OFF) / 4; u += NTHREADS) ((LAS unsigned*)(lds + LDSCTL_OFF))[u] = 0u;
    __syncthreads();
    XcdBarrier bar = xcd_barrier_post((unsigned*)(ws + WS_CTL) + CW_BAR, (volatile LAS unsigned*)(lds + MISC_OFF) + 8);
    if (args.ph_hi > 1000) grid.sync();
#define SEAM(k) do { if (IN(k) && IN((k) + 1)) xcd_barrier(bar); } while (0)
    bf16 *Hb = (bf16*)(ws + WS_H), *Qb = (bf16*)(ws + WS_Q), *Kb = (bf16*)(ws + WS_K), *Vb = (bf16*)(ws + WS_V), *ZAb = (bf16*)(ws + WS_ZA), *UZb = (bf16*)(ws + WS_UZ), *GVb = (bf16*)(ws + WS_GV);
    bf16 *GAb = (bf16*)args.out, *GBb = (bf16*)args.out + (size_t)M * DM;
    float* part = (float*)(ws + WS_PART); float* part2 = (float*)(ws + WS_PART2);

    if (IN(0)) { p0_prologue(args, lds, vcu, G, wave, lane); }
    SEAM(0);
    if (IN(1)) {
        pg8::Gemm g{Hb, (const bf16*)(ws + WS_WTIN), M, NIN, DM}; pg8::StaticOrder S; S.init(M, NIN, G, bx);
        EpiInProj E{Qb, Kb, Vb, ZAb, UZb, GVb, GAb, GBb, part};
        pg8::gemm_phase<EpiInProj, pg8::StaticOrder, true, true>(lds, g, S, E);
    }
    SEAM(1);
    if (IN(2)) {
        const float lam = ((const float*)(ws + WS_LAM))[0];
        for (int pi = vcu; pi < 256; pi += G) {
            const int bh = pi >> 3, s = pi & 7;
#ifndef NO_ATT
            att::unit(bh >> 3, bh & 7, 15 - s, Qb, Kb, Vb, ZAb, args.in[7], lam, lds);
            att::unit(bh >> 3, bh & 7, s, Qb, Kb, Vb, ZAb, args.in[7], lam, lds);
#endif
        }
        for (int u = vcu; u < 1024; u += G) gm::unit(u >> 3, u & 7, UZb, GVb, part, (const bf16*)(ws + WS_WS), args.in[8], args.in[9], args.in[11], lds);
    }
    if (IN(6)) {
        const float lam = ((const float*)(ws + WS_LAM))[0];
        for (int pi = vcu; pi < 256; pi += G) { const int bh = pi >> 3, s = pi & 7;
            att::unit(bh >> 3, bh & 7, 15 - s, Qb, Kb, Vb, ZAb, args.in[7], lam, lds, true); att::unit(bh >> 3, bh & 7, s, Qb, Kb, Vb, ZAb, args.in[7], lam, lds, true); }
    }
    if (IN(7)) {
        for (int u = vcu; u < 1024; u += G) gm::unit(u >> 3, u & 7, UZb, GVb, part, (const bf16*)(ws + WS_WS), args.in[8], args.in[9], args.in[11], lds, true);
    }
    SEAM(2);
    if (IN(3)) {
        float* T = (float*)(ws + WS_K);
        { pg8::Gemm g{Qb, (const bf16*)(ws + WS_WTA), M, DM, DM}; pg8::StaticOrder S; S.init(M, DM, G, bx); EpiMerge1 E{GAb, T};
          pg8::gemm_phase<EpiMerge1, pg8::StaticOrder, true, true>(lds, g, S, E); }
        __syncthreads();
        { pg8::Gemm g{UZb, (const bf16*)(ws + WS_WTB), M, DM, DM}; pg8::StaticOrder S; S.init(M, DM, G, bx); EpiMerge2 E{GBb, T, Hb};
          pg8::gemm_phase<EpiMerge2, pg8::StaticOrder, true, true>(lds, g, S, E); }
    }
    SEAM(3);
    if (IN(4)) {
        pg8::Gemm g{Hb, (const bf16*)(ws + WS_WTO), M, DM, DM}; pg8::StaticOrder S; S.init(M, DM, G, bx); EpiOut E{args.in[0], args.out, part2};
        pg8::gemm_phase<EpiOut, pg8::StaticOrder, true, true>(lds, g, S, E);
    }
    SEAM(4);
    if (IN(5)) {
        const int gw = vcu * NWAVES + wave, NGW = G * NWAVES; const float* fg = args.in[15];
        f32x4 g4[4];
#pragma unroll
        for (int j = 0; j < 4; ++j) g4[j] = ((const f32x4*)fg)[64 * j + lane];
        for (int m = gw; m < M; m += NGW) {
            float s = (lane < 16) ? part2[(size_t)m * 16 + lane] : 0.f;
            s = wave_sum(s);
            const float rstd = 1.0f / sqrtf(s * (1.f / DM) + 1e-6f);
            f32x4* xr = (f32x4*)(args.out + (size_t)m * DM) + lane;
#pragma unroll
            for (int j = 0; j < 4; ++j) xr[64 * j] = xr[64 * j] * rstd * g4[j];
        }
    }
#undef IN
#undef SEAM
}

extern "C" void kernel_launch(void* const* d_in, const int* in_sizes, int n_in, void* d_out, int out_size, void* d_ws, size_t ws_size, hipStream_t stream) {
    static int grid = 0;
    if (grid == 0) {
        if (n_in != 16 || out_size != M * DM || ws_size < WS_END) { fprintf(stderr, "kernel_launch: unexpected shapes (n_in %d out %d ws %zu)\n", n_in, out_size, ws_size); grid = -1; return; }
        int dev = 0, cus = 0, per_cu = 0;
        hipGetDevice(&dev); hipDeviceGetAttribute(&cus, hipDeviceAttributeMultiprocessorCount, dev);
        hipFuncSetAttribute((const void*)fwd_kernel, hipFuncAttributeMaxDynamicSharedMemorySize, LDS_BYTES);
        hipOccupancyMaxActiveBlocksPerMultiprocessor(&per_cu, (const void*)fwd_kernel, NTHREADS, LDS_BYTES);
        if (per_cu < 1) per_cu = 1;
        grid = cus * per_cu;
        (void)hipGetLastError();
    }
    if (grid < 0) return;
    (void)hipMemsetAsync((char*)d_ws + WS_CTL, 0, CTL_ZERO_BYTES, stream);
    Args a{};
    for (int i = 0; i < 16; ++i) a.in[i] = (const float*)d_in[i];
    a.out = (float*)d_out; a.ws = (unsigned char*)d_ws;
#if MK_N_LAUNCHES == 1
    a.ph_lo = 0; a.ph_hi = N_PHASES;
    void* kargs[] = {&a};
    hipError_t e = hipLaunchCooperativeKernel((const void*)fwd_kernel, dim3(grid), dim3(NTHREADS), kargs, LDS_BYTES, stream);
    if (e != hipSuccess) fprintf(stderr, "cooperative launch failed: %s (grid %d)\n", hipGetErrorString(e), grid);
#else
    { const int seq[] = {PROBE_SEQ};
      for (int i = 0; i < (int)(sizeof(seq) / sizeof(int)); ++i) { a.ph_lo = seq[i]; a.ph_hi = seq[i] + 1; hipLaunchKernelGGL(fwd_kernel, dim3(grid), dim3(NTHREADS), LDS_BYTES, stream, a); } }
#endif
}
```

```cpp
#include <hip/hip_runtime.h>
#include <hip/hip_cooperative_groups.h>
#include <cstdio>
#include <cstdint>
#include <cmath>
namespace cg = cooperative_groups;
namespace pg8 {
#define PG8_LAS __attribute__((address_space(3)))
typedef unsigned short bf16_t;
typedef short bf16x8 __attribute__((ext_vector_type(8)));
typedef float f32x4 __attribute__((ext_vector_type(4)));
typedef unsigned u32x4 __attribute__((ext_vector_type(4)));
constexpr int BM = 256, BK = 64, HALF = 128, HTB = HALF * BK * 2  , STAGE_BYTES = 8 * HTB, NXCD = 8, WGM = 8;

__host__ __device__ __forceinline__ int lds_byte(int r, int c) { const int st = (r >> 4) * 2 + (c >> 5), rr = r & 15, cc = c & 31, ob = rr * 64 + cc * 2; return st * 1024 + (ob ^ (((ob >> 9) & 1) << 5)); }
__host__ __device__ __forceinline__ void stage_rc(int b, int& R, int& C) { const int st = b / 1024, sb = b % 1024, swz = sb ^ (((sb >> 9) & 1) << 5); R = (st >> 1) * 16 + swz / 64; C = (st & 1) * 32 + (swz % 64) / 2; }
__host__ __device__ __forceinline__ int perm32(int rho) { const int n = rho >> 4, i = rho & 15; return 8 * (i >> 2) + 4 * n + (i & 3); }

struct Unit { int pm, pn; };
struct Gemm { const bf16_t* A; const bf16_t* Bt; int M, N, K; };

struct StaticOrder {
    int nM, nN, nwg, G, c;
    __host__ __device__ void init(int M, int N, int G_, int c_) { nM = M / BM; nN = N / BM; nwg = nM * nN; G = G_; c = c_; }
    __host__ __device__ bool next(int i, Unit& u) const {
        const long L = (long)i * G + c; if (L >= nwg) return false;
        int wgid = (int)L; { const int q = nwg / NXCD, r = nwg % NXCD, xcd = wgid % NXCD, off = wgid / NXCD; wgid = (xcd < r ? xcd * (q + 1) : r * (q + 1) + (xcd - r) * q) + off; }
        const int nig = WGM * nN, gid = wgid / nig, fm = gid * WGM, gsz = (nM - fm) < WGM ? (nM - fm) : WGM;
        u.pm = fm + ((wgid % nig) % gsz); u.pn = (wgid % nig) / gsz; return true;
    }
    __device__ __forceinline__ void a_ready(const Unit&) const {}
    __device__ __forceinline__ void done(const Unit&) const {}
};

__device__ __forceinline__ unsigned cvt_pk_bf16(float lo, float hi) { unsigned r; asm volatile("v_cvt_pk_bf16_f32 %0, %1, %2" : "=v"(r) : "v"(lo), "v"(hi)); return r; }
typedef float f32x2 __attribute__((ext_vector_type(2)));
template <class Epi, class Sched, bool ALIGN_EPI = false, bool SP2 = false>
__device__ __forceinline__ void gemm_phase(PG8_LAS unsigned char* lds, const Gemm g, const Sched& S, const Epi& E) {
    const int tid = threadIdx.x, wid = __builtin_amdgcn_readfirstlane(tid >> 6), lane = tid & 63, wr = wid >> 2, wc = wid & 3, fr = lane & 15, fq = lane >> 4;
    const int K = g.K, nt = K / BK;
    unsigned voffA[2], voffB[2];
#pragma unroll
    for (int i = 0; i < 2; ++i) { int R, C; stage_rc(tid * 16 + i * 8192, R, C); const int Rb = Epi::PERM ? ((R & ~31) + perm32(R & 31)) : R;
        voffA[i] = (unsigned)(R * K + C) * 2u; voffB[i] = (unsigned)(Rb * K + C) * 2u; }
    const size_t kstep = (size_t)(BK * 2);
    const size_t hstep = (size_t)HALF * K * 2;
    const size_t tstep = 2 * hstep;
    const unsigned ldsw = (unsigned)wid * 1024u;
    const int aoff = lds_byte(wr * 64 + fr, fq * 8), boff = lds_byte(wc * 32 + fr, fq * 8);
#define PG8_SA(b, h) (((b) * 2 + (h)) * HTB)
#define PG8_SB(b, h) ((4 + (b) * 2 + (h)) * HTB)
#define PG8_STAGE(bufoff, gbase, voff) do { _Pragma("unroll") for (int _i = 0; _i < 2; ++_i) \
        __builtin_amdgcn_global_load_lds((const unsigned*)((const char*)(gbase) + (voff)[_i]), (PG8_LAS unsigned*)(lds + (bufoff) + ldsw + _i * 8192), 16, 0, 0); } while (0)
#define PG8_LDA(dst, b, h) do { _Pragma("unroll") for (int m = 0; m < 4; ++m) _Pragma("unroll") for (int k = 0; k < 2; ++k) dst[m][k] = *(const PG8_LAS bf16x8*)(lds + PG8_SA(b, h) + aoff + m * 2048 + k * 1024); } while (0)
#define PG8_LDB(dst, b, h) do { _Pragma("unroll") for (int n = 0; n < 2; ++n) _Pragma("unroll") for (int k = 0; k < 2; ++k) dst[n][k] = *(const PG8_LAS bf16x8*)(lds + PG8_SB(b, h) + boff + n * 2048 + k * 1024); } while (0)
#define PG8_MMA(ai, bj, At, Bt) do { __builtin_amdgcn_s_setprio(1); _Pragma("unroll") for (int m = 0; m < 4; ++m) _Pragma("unroll") for (int n = 0; n < 2; ++n) _Pragma("unroll") for (int k = 0; k < 2; ++k) \
        acc[ai][bj][m][n] = __builtin_amdgcn_mfma_f32_16x16x32_bf16(Bt[n][k], At[m][k], acc[ai][bj][m][n], 0, 0, 0); __builtin_amdgcn_s_setprio(0); } while (0)
#define PG8_WAIT_V(n) asm volatile("s_waitcnt vmcnt(" #n ")" ::: "memory")
#define PG8_WAIT_L(n) asm volatile("s_waitcnt lgkmcnt(" #n ")" ::: "memory")
#define PG8_BAR __builtin_amdgcn_s_barrier()
#define PG8_SCHED __builtin_amdgcn_sched_barrier(0)
    Unit cur, nxt; int ui = 0;
    if (!S.next(0, cur)) return;
    f32x4 acc[2][2][4][2];
#pragma unroll
    for (int a = 0; a < 2; ++a)
#pragma unroll
        for (int b = 0; b < 2; ++b)
#pragma unroll
            for (int m = 0; m < 4; ++m)
#pragma unroll
                for (int n = 0; n < 2; ++n) acc[a][b][m][n] = (f32x4){0.f, 0.f, 0.f, 0.f};
    bf16x8 At[4][2], B0[2][2], B1[2][2];
    const char* cA = (const char*)g.A + (size_t)cur.pm * tstep; const char* cB = (const char*)g.Bt + (size_t)cur.pn * tstep;
    S.a_ready(cur);
    if constexpr (SP2) {
        PG8_STAGE(PG8_SB(0, 0), cB, voffB); PG8_STAGE(PG8_SB(0, 1), cB + hstep, voffB); PG8_STAGE(PG8_SA(0, 0), cA, voffA); PG8_STAGE(PG8_SA(0, 1), cA + hstep, voffA);
        if (wr == 1) PG8_BAR;
        PG8_WAIT_V(2); PG8_BAR;
        PG8_STAGE(PG8_SB(1, 0), cB + kstep, voffB); PG8_STAGE(PG8_SA(1, 0), cA + kstep, voffA); PG8_STAGE(PG8_SB(1, 1), cB + hstep + kstep, voffB);
        PG8_WAIT_V(6); PG8_BAR;
    } else {
        PG8_STAGE(PG8_SB(0, 0), cB, voffB); PG8_STAGE(PG8_SA(0, 0), cA, voffA); PG8_STAGE(PG8_SB(0, 1), cB + hstep, voffB); PG8_STAGE(PG8_SA(0, 1), cA + hstep, voffA);
        if (wr == 1) PG8_BAR;
        PG8_WAIT_V(4); PG8_BAR;
        PG8_STAGE(PG8_SB(1, 0), cB + kstep, voffB); PG8_STAGE(PG8_SA(1, 0), cA + kstep, voffA); PG8_STAGE(PG8_SB(1, 1), cB + hstep + kstep, voffB);
        PG8_WAIT_V(6); PG8_BAR;
    }
    for (;;) {
        const bool has_next = S.next(ui + 1, nxt);
        const char* nA = has_next ? (const char*)g.A + (size_t)nxt.pm * tstep : cA; const char* nB = has_next ? (const char*)g.Bt + (size_t)nxt.pn * tstep : cB;
        for (int t = 0; t < nt; t += 2) {
            const bool last = (t == nt - 2);
            const char* a1 = cA + (size_t)(t + 1) * kstep;
            const char* a2 = last ? nA : cA + (size_t)(t + 2) * kstep; const char* b2 = last ? nB : cB + (size_t)(t + 2) * kstep;
            const char* a3 = a2 + kstep; const char* b3 = b2 + kstep;
            if (last && has_next) S.a_ready(nxt);
            if constexpr (SP2) {
            PG8_LDB(B0, 0, 0); PG8_LDB(B1, 0, 1); PG8_SCHED; PG8_LDA(At, 0, 0); PG8_STAGE(PG8_SA(1, 1), a1 + hstep, voffA);
            PG8_WAIT_V(8); PG8_WAIT_L(0); PG8_BAR; PG8_MMA(0, 0, At, B0); PG8_MMA(0, 1, At, B1); PG8_BAR; PG8_SCHED;
            PG8_LDA(At, 0, 1); PG8_STAGE(PG8_SB(0, 0), b2, voffB); PG8_STAGE(PG8_SB(0, 1), b2 + hstep, voffB); PG8_STAGE(PG8_SA(0, 0), a2, voffA);
            PG8_WAIT_V(8); PG8_WAIT_L(0); PG8_BAR; PG8_MMA(1, 0, At, B0); PG8_MMA(1, 1, At, B1); PG8_BAR; PG8_SCHED;
            PG8_LDB(B0, 1, 0); PG8_LDB(B1, 1, 1); PG8_SCHED; PG8_LDA(At, 1, 0); PG8_STAGE(PG8_SA(0, 1), a2 + hstep, voffA);
            PG8_WAIT_V(8); PG8_WAIT_L(0); PG8_BAR; PG8_MMA(0, 0, At, B0); PG8_MMA(0, 1, At, B1); PG8_BAR; PG8_SCHED;
            PG8_LDA(At, 1, 1); PG8_STAGE(PG8_SB(1, 0), b3, voffB); PG8_STAGE(PG8_SB(1, 1), b3 + hstep, voffB); PG8_STAGE(PG8_SA(1, 0), a3, voffA);
            PG8_WAIT_V(8); PG8_WAIT_L(0); PG8_BAR; PG8_MMA(1, 0, At, B0); PG8_MMA(1, 1, At, B1); PG8_BAR; PG8_SCHED;
            } else {
            PG8_LDB(B0, 0, 0); PG8_SCHED; PG8_LDA(At, 0, 0); PG8_STAGE(PG8_SA(1, 1), a1 + hstep, voffA);
            PG8_WAIT_L(8); PG8_BAR; PG8_WAIT_L(0); PG8_MMA(0, 0, At, B0); PG8_BAR; PG8_SCHED;
            PG8_LDB(B1, 0, 1); PG8_STAGE(PG8_SB(0, 0), b2, voffB);
            PG8_BAR; PG8_WAIT_L(0); PG8_MMA(0, 1, At, B1); PG8_BAR;
            PG8_LDA(At, 0, 1); PG8_STAGE(PG8_SA(0, 0), a2, voffA);
            PG8_BAR; PG8_WAIT_L(0); PG8_MMA(1, 0, At, B0); PG8_BAR; PG8_SCHED;
            PG8_STAGE(PG8_SB(0, 1), b2 + hstep, voffB);
            PG8_WAIT_V(6); PG8_BAR; PG8_MMA(1, 1, At, B1); PG8_BAR;
            PG8_LDB(B0, 1, 0); PG8_SCHED; PG8_LDA(At, 1, 0); PG8_STAGE(PG8_SA(0, 1), a2 + hstep, voffA);
            PG8_WAIT_L(8); PG8_BAR; PG8_WAIT_L(0); PG8_MMA(0, 0, At, B0); PG8_BAR; PG8_SCHED;
            PG8_LDB(B1, 1, 1); PG8_STAGE(PG8_SB(1, 0), b3, voffB);
            PG8_BAR; PG8_WAIT_L(0); PG8_MMA(0, 1, At, B1); PG8_BAR;
            PG8_LDA(At, 1, 1); PG8_STAGE(PG8_SA(1, 0), a3, voffA);
            PG8_BAR; PG8_WAIT_L(0); PG8_MMA(1, 0, At, B0); PG8_BAR; PG8_SCHED;
            PG8_STAGE(PG8_SB(1, 1), b3 + hstep, voffB);
            PG8_WAIT_V(6); PG8_BAR; PG8_MMA(1, 1, At, B1); PG8_BAR;
            }
        }
        if constexpr (ALIGN_EPI) { if (wr == 0) PG8_BAR; }
        bool keep_acc = false;
        if constexpr (Epi::CHAIN) { if (cur.pm < Epi::CHAIN_PM) { E.mid(acc, cur, wr, wc, fr, fq); keep_acc = true; } else { E(acc, cur, wr, wc, fr, fq); } S.done(cur); } else
        if constexpr (!Epi::AFTER_DRAIN) { E(acc, cur, wr, wc, fr, fq); S.done(cur); }
        if (!has_next) break;
        if (!keep_acc)
#pragma unroll
        for (int a = 0; a < 2; ++a)
#pragma unroll
            for (int b = 0; b < 2; ++b)
#pragma unroll
                for (int m = 0; m < 4; ++m)
#pragma unroll
                    for (int n = 0; n < 2; ++n) acc[a][b][m][n] = (f32x4){0.f, 0.f, 0.f, 0.f};
        cur = nxt; cA = nA; cB = nB; ++ui;
        if constexpr (ALIGN_EPI) { if (wr == 1) PG8_BAR; }
    }
    PG8_WAIT_V(0);
    if constexpr (!ALIGN_EPI) { if (wr == 0) PG8_BAR; }
    PG8_BAR;
    if constexpr (Epi::AFTER_DRAIN) { E.fused(acc, cur, wr, wc, fr, fq, lds, wid, lane); S.done(cur); }
#undef PG8_SA
#undef PG8_SB
#undef PG8_STAGE
#undef PG8_LDA
#undef PG8_LDB
#undef PG8_MMA
#undef PG8_WAIT_V
#undef PG8_WAIT_L
#undef PG8_BAR
#undef PG8_SCHED
}
}

#ifndef MK_N_LAUNCHES
#define MK_N_LAUNCHES 1
#endif
#ifndef PROBE_SEQ
#define PROBE_SEQ 0, 1, 2, 3, 4, 5
#endif
constexpr int NB = 4, SEQ = 4096, DM = 1024, M = NB * SEQ, NIN = 9216;
constexpr int NWAVES = 8, NTHREADS = 512, N_PHASES = 6;
constexpr size_t MiB = 1u << 20;
constexpr size_t WS_CTL = 0, WS_WS = 1 * MiB, WS_PART = 2 * MiB, WS_PART2 = 4 * MiB, WS_WTA = 6 * MiB, WS_WTB = 8 * MiB, WS_WTO = 10 * MiB,
                 WS_WTIN = 12 * MiB, WS_H = 32 * MiB, WS_Q = 64 * MiB, WS_K = 96 * MiB, WS_V = 128 * MiB, WS_ZA = 160 * MiB, WS_UZ = 192 * MiB,
                 WS_GV = 224 * MiB, WS_END = 256 * MiB;
constexpr int RING_BYTES = 131072, LDS_BYTES = 147456, LDSCTL_OFF = RING_BYTES, MISC_OFF = LDSCTL_OFF + 320;
constexpr size_t CTL_ZERO_BYTES = 65536, CW_BAR = 4096, WS_LAM = 65536;
constexpr float QSCALE = 0.125f * 1.4426950408889634f;
constexpr float LOG2E = 1.4426950408889634f;

#define LAS __attribute__((address_space(3)))
typedef unsigned short bf16;
typedef unsigned v4u __attribute__((ext_vector_type(4)));
typedef unsigned v2u __attribute__((ext_vector_type(2)));
typedef float f32x4 __attribute__((ext_vector_type(4)));
typedef float f32x2 __attribute__((ext_vector_type(2)));
typedef float f32x16 __attribute__((ext_vector_type(16)));
typedef short bf16x8 __attribute__((ext_vector_type(8)));
typedef short s16x4 __attribute__((ext_vector_type(4)));
typedef __bf16 bf16x2_t __attribute__((ext_vector_type(2)));

__device__ __forceinline__ unsigned pk2(float lo, float hi) { f32x2 v = {lo, hi}; bf16x2_t b = __builtin_convertvector(v, bf16x2_t); return __builtin_bit_cast(unsigned, b); }
__device__ __forceinline__ float bflo(unsigned u) { return __uint_as_float(u << 16); }
__device__ __forceinline__ float bfhi(unsigned u) { return __uint_as_float(u & 0xffff0000u); }
__device__ __forceinline__ float fast_sigmoid(float x) { return __builtin_amdgcn_rcpf(1.f + __builtin_amdgcn_exp2f(-LOG2E * x)); }
__device__ __forceinline__ float silu_f(float x) { return x * fast_sigmoid(x); }
__device__ __forceinline__ float gelu_tanh_f(float x) { return x * fast_sigmoid(1.5957691216057308f * (x + 0.044715f * x * x * x)); }
__device__ __forceinline__ float wave_sum(float v) {
#pragma unroll
    for (int o = 1; o < 64; o <<= 1) v += __shfl_xor(v, o);
    return v;
}
__device__ __forceinline__ int crow(int r, int hi) { return (r & 3) + 8 * (r >> 2) + 4 * hi; }

struct EpiInProj {
    static constexpr bool PERM = true, AFTER_DRAIN = false, CHAIN = false;
    bf16 *Q, *K, *V, *ZA, *UZ, *GV, *GA, *GB; float* part;
    template <int ACT> __device__ __forceinline__ void plain(const pg8::f32x4 (&acc)[2][2][4][2], bf16* base, int row0, int col0, int pn, int wc, int fq) const {
#pragma unroll
        for (int ai = 0; ai < 2; ++ai)
#pragma unroll
            for (int m = 0; m < 4; ++m) {
                const int row = row0 + ai * 128 + m * 16; bf16* rowp = base + (size_t)row * DM + col0;
                float s1 = 0.f, s2 = 0.f;
#pragma unroll
                for (int bj = 0; bj < 2; ++bj) {
                    float v[8];
#pragma unroll
                    for (int j = 0; j < 4; ++j) { v[j] = acc[ai][bj][m][0][j]; v[4 + j] = acc[ai][bj][m][1][j]; }
#pragma unroll
                    for (int j = 0; j < 8; ++j) {
                        if (ACT == 1) v[j] *= QSCALE;
                        if (ACT == 2) v[j] = silu_f(v[j]);
                        if (ACT == 3) { v[j] = gelu_tanh_f(v[j]); s1 += v[j]; s2 += v[j] * v[j]; }
                        if (ACT == 4) v[j] = fast_sigmoid(v[j]);
                    }
                    v4u w; w.x = pk2(v[0], v[1]); w.y = pk2(v[2], v[3]); w.z = pk2(v[4], v[5]); w.w = pk2(v[6], v[7]);
                    *(v4u*)(rowp + bj * 128) = w;
                }
                if (ACT == 3) {
                    s1 += __shfl_xor(s1, 16); s1 += __shfl_xor(s1, 32); s2 += __shfl_xor(s2, 16); s2 += __shfl_xor(s2, 32);
                    if (fq == 0) *(f32x2*)(part + ((size_t)row * 16 + (pn - 24) * 4 + wc) * 2) = (f32x2){s1, s2};
                }
            }
    }
    __device__ __forceinline__ void operator()(const pg8::f32x4 (&acc)[2][2][4][2], const pg8::Unit& u, int wr, int wc, int fr, int fq) const {
        const int pn = u.pn, row0 = u.pm * 256 + wr * 64 + fr, cw = wc * 32 + 8 * fq;
        if (pn >= 16 && pn < 24) {
            const int j = pn - 16;
#pragma unroll
            for (int ai = 0; ai < 2; ++ai)
#pragma unroll
                for (int m = 0; m < 4; ++m) {
                    const int row = row0 + ai * 128 + m * 16; float v[8];
#pragma unroll
                    for (int n = 0; n < 2; ++n)
#pragma unroll
                        for (int e = 0; e < 4; ++e) v[4 * n + e] = gelu_tanh_f(acc[ai][0][m][n][e]) * silu_f(acc[ai][1][m][n][e]);
                    v4u w; w.x = pk2(v[0], v[1]); w.y = pk2(v[2], v[3]); w.z = pk2(v[4], v[5]); w.w = pk2(v[6], v[7]);
                    *(v4u*)(UZ + (size_t)row * DM + j * 128 + cw) = w;
                }
            return;
        }
        const int sec = pn >> 2, col0 = (pn & 3) * 256 + cw;
        if (sec == 0) plain<1>(acc, Q, row0, col0, pn, wc, fq);
        else if (sec == 1) plain<0>(acc, K, row0, col0, pn, wc, fq);
        else if (sec == 2) plain<0>(acc, V, row0, col0, pn, wc, fq);
        else if (sec == 3) plain<2>(acc, ZA, row0, col0, pn, wc, fq);
        else if (sec == 6) plain<3>(acc, GV, row0, col0, pn, wc, fq);
        else if (sec == 7) plain<4>(acc, GA, row0, col0, pn, wc, fq);
        else plain<4>(acc, GB, row0, col0, pn, wc, fq);
    }
};
struct EpiMergeChain {
    static constexpr bool PERM = true, AFTER_DRAIN = false, CHAIN = true; static constexpr int CHAIN_PM = 256;
    const bf16 *GA, *GB; bf16* O;
    __device__ __forceinline__ void mid(pg8::f32x4 (&acc)[2][2][4][2], const pg8::Unit& u, int wr, int wc, int fr, int fq) const {
        const int row0 = u.pm * 256 + wr * 64 + fr, col0 = u.pn * 256 + wc * 32 + 8 * fq;
#pragma unroll
        for (int ai = 0; ai < 2; ++ai)
#pragma unroll
            for (int m = 0; m < 4; ++m)
#pragma unroll
                for (int bj = 0; bj < 2; ++bj) {
                    const size_t off = (size_t)(row0 + ai * 128 + m * 16) * DM + col0 + bj * 128;
                    const v4u a = *(const v4u*)(GA + off), b = *(const v4u*)(GB + off);
                    pg8::f32x4& t0 = acc[ai][bj][m][0]; pg8::f32x4& t1 = acc[ai][bj][m][1];
                    t0[0] *= bflo(a.x) * __builtin_amdgcn_rcpf(bflo(b.x)); t0[1] *= bfhi(a.x) * __builtin_amdgcn_rcpf(bfhi(b.x));
                    t0[2] *= bflo(a.y) * __builtin_amdgcn_rcpf(bflo(b.y)); t0[3] *= bfhi(a.y) * __builtin_amdgcn_rcpf(bfhi(b.y));
                    t1[0] *= bflo(a.z) * __builtin_amdgcn_rcpf(bflo(b.z)); t1[1] *= bfhi(a.z) * __builtin_amdgcn_rcpf(bfhi(b.z));
                    t1[2] *= bflo(a.w) * __builtin_amdgcn_rcpf(bflo(b.w)); t1[3] *= bfhi(a.w) * __builtin_amdgcn_rcpf(bfhi(b.w));
                }
    }
    __device__ __forceinline__ void operator()(const pg8::f32x4 (&acc)[2][2][4][2], const pg8::Unit& u, int wr, int wc, int fr, int fq) const {
        const int row0 = (u.pm - 256) * 256 + wr * 64 + fr, col0 = (u.pn - 4) * 256 + wc * 32 + 8 * fq;
#pragma unroll
        for (int ai = 0; ai < 2; ++ai)
#pragma unroll
            for (int m = 0; m < 4; ++m)
#pragma unroll
                for (int bj = 0; bj < 2; ++bj) {
                    const size_t off = (size_t)(row0 + ai * 128 + m * 16) * DM + col0 + bj * 128;
                    const v4u g = *(const v4u*)(GB + off);
                    const pg8::f32x4 a0 = acc[ai][bj][m][0], a1 = acc[ai][bj][m][1];
                    v4u w; w.x = pk2(a0[0] * bflo(g.x), a0[1] * bfhi(g.x)); w.y = pk2(a0[2] * bflo(g.y), a0[3] * bfhi(g.y));
                    w.z = pk2(a1[0] * bflo(g.z), a1[1] * bfhi(g.z)); w.w = pk2(a1[2] * bflo(g.w), a1[3] * bfhi(g.w));
                    *(v4u*)(O + off) = w;
                }
    }
};
struct MergeOrder {
    pg8::StaticOrder base;
    __device__ void init(int G, int c) { base.init(M, DM, G, c); }
    __device__ bool next(int i, pg8::Unit& u) const { pg8::Unit b; if (!base.next(i >> 1, b)) return false; u.pm = b.pm + ((i & 1) ? 256 : 0); u.pn = b.pn + ((i & 1) ? 4 : 0); return true; }
    __device__ __forceinline__ void a_ready(const pg8::Unit&) const {}
    __device__ __forceinline__ void done(const pg8::Unit&) const {}
};
struct EpiOut {
    static constexpr bool PERM = false, AFTER_DRAIN = false, CHAIN = false;
    const float* X; float* O; float* part2;
    __device__ __forceinline__ void operator()(const pg8::f32x4 (&acc)[2][2][4][2], const pg8::Unit& u, int wr, int wc, int fr, int fq) const {
        const int row0 = u.pm * 256 + wr * 64 + fr, col0 = u.pn * 256 + wc * 32 + 4 * fq;
#pragma unroll
        for (int ai = 0; ai < 2; ++ai)
#pragma unroll
            for (int m = 0; m < 4; ++m) {
                const int row = row0 + ai * 128 + m * 16; float s2 = 0.f;
#pragma unroll
                for (int bj = 0; bj < 2; ++bj)
#pragma unroll
                    for (int n = 0; n < 2; ++n) {
                        const size_t off = (size_t)row * DM + col0 + bj * 128 + n * 16;
                        const f32x4 v = *(const f32x4*)(X + off) + acc[ai][bj][m][n];
                        s2 += (v[0] * v[0] + v[1] * v[1]) + (v[2] * v[2] + v[3] * v[3]);
                        *(f32x4*)(O + off) = v;
                    }
                s2 += __shfl_xor(s2, 16); s2 += __shfl_xor(s2, 32);
                if (fq == 0) part2[(size_t)row * 16 + u.pn * 4 + wc] = s2;
            }
    }
};

__device__ __forceinline__ int win_src_col(int n) {
    const int pn = n >> 8, cc = n & 255;
    if (pn < 16) return n;
    if (pn < 24) { const int j = pn - 16; return cc < 128 ? 4096 + 128 * j + cc : 6144 + 128 * j + (cc - 128); }
    if (pn < 28) return 5120 + (n - 24 * 256);
    return 7168 + (n - 28 * 256);
}
__device__ __forceinline__ void p0_transpose_item(const float* W, int K, int N, bf16* WT, bool permute, LAS float* scr, int item, int lane) {
    const int nblk = N / 32, kb = item / nblk, nb = item % nblk, k0 = 64 * kb, n0 = 32 * nb;
    const int n0s = permute ? win_src_col(n0) : n0;
#pragma unroll 8
    for (int i = 0; i < 32; ++i) { const int kk = 2 * i + (lane >> 5); scr[kk * 33 + (lane & 31)] = W[(size_t)(k0 + kk) * N + n0s + (lane & 31)]; }
    asm volatile("s_waitcnt lgkmcnt(0)" ::: "memory");
    const int c = lane & 7;
#pragma unroll
    for (int j = 0; j < 4; ++j) { const int n = (lane >> 3) + 8 * j; const LAS float* s = scr + (8 * c) * 33 + n;
        v4u o; o.x = pk2(s[0 * 33], s[1 * 33]); o.y = pk2(s[2 * 33], s[3 * 33]); o.z = pk2(s[4 * 33], s[5 * 33]); o.w = pk2(s[6 * 33], s[7 * 33]);
        *(v4u*)(WT + (size_t)(n0 + n) * K + k0 + 8 * c) = o; }
    asm volatile("s_waitcnt lgkmcnt(0)" ::: "memory");
}

struct Args { const float* in[16]; float* out; unsigned char* ws; int ph_lo, ph_hi; };

__device__ __forceinline__ void p0_prologue(const Args& a, LAS unsigned char* lds, int vcu, int G, int wave, int lane) {
    unsigned char* ws = a.ws;
    LAS float* scr = (LAS float*)(lds + wave * 16384);
    const int gw = vcu * NWAVES + wave, NGW = G * NWAVES;
    constexpr int I_IN = (DM / 64) * (NIN / 32), I_SQ = (DM / 64) * (DM / 32);
    constexpr int NITEMS = I_IN + 3 * I_SQ;
    for (int it = gw; it < NITEMS; it += NGW) {
        int r = it;
        if (r < I_IN) { p0_transpose_item(a.in[2], DM, NIN, (bf16*)(ws + WS_WTIN), true, scr, r, lane); continue; } r -= I_IN;
        if (r < I_SQ) { p0_transpose_item(a.in[12], DM, DM, (bf16*)(ws + WS_WTA), false, scr, r, lane); continue; } r -= I_SQ;
        if (r < I_SQ) { p0_transpose_item(a.in[13], DM, DM, (bf16*)(ws + WS_WTB), false, scr, r, lane); continue; } r -= I_SQ;
        p0_transpose_item(a.in[14], DM, DM, (bf16*)(ws + WS_WTO), false, scr, r, lane);
    }
    const float* x = a.in[0]; const float* ng = a.in[1]; bf16* H = (bf16*)(ws + WS_H);
    f32x4 g4[4];
#pragma unroll
    for (int j = 0; j < 4; ++j) g4[j] = ((const f32x4*)ng)[64 * j + lane];
    for (int m = gw; m < M; m += NGW) {
        const f32x4* xr = (const f32x4*)(x + (size_t)m * DM) + lane; f32x4 v[4]; float s = 0.f;
#pragma unroll
        for (int j = 0; j < 4; ++j) { v[j] = xr[64 * j]; s += (v[j][0] * v[j][0] + v[j][1] * v[j][1]) + (v[j][2] * v[j][2] + v[j][3] * v[j][3]); }
        const float rstd = 1.0f / sqrtf(wave_sum(s) * (1.f / DM) + 1e-6f);
        v2u* o8 = (v2u*)(H + (size_t)m * DM) + lane;
#pragma unroll
        for (int j = 0; j < 4; ++j) { const f32x4 y = v[j] * rstd * g4[j]; o8[64 * j] = (v2u){pk2(y[0], y[1]), pk2(y[2], y[3])}; }
    }
    const float* w_s = a.in[10]; bf16* WSb = (bf16*)(ws + WS_WS);
    for (int i = gw * 64 + lane; i < 8 * 128 * 128; i += NGW * 64) { const int t = (i >> 7) & 127, s = i & 127; const float v = (s <= t) ? w_s[i] : 0.f; WSb[i] = (bf16)(pk2(v, 0.f) & 0xffffu); }
    if (gw == 0) {
        const float sa = wave_sum(a.in[3][lane] * a.in[4][lane]), sb = wave_sum(a.in[5][lane] * a.in[6][lane]);
        if (lane == 0) ((float*)(ws + WS_LAM))[0] = expf(sa) - expf(sb) + 0.2f;
    }
}

namespace att {
constexpr int L_K = 0, L_V = 16384, L_WSF = 49152, L_ST = 53248, L_END = L_ST + 65536;
__device__ __forceinline__ s16x4 vtr(const LAS unsigned char* p) { typedef short v4i16_t __attribute__((ext_vector_type(4))); return __builtin_bit_cast(s16x4, __builtin_amdgcn_ds_read_tr16_b64_v4i16((LAS v4i16_t*)p)); }
#define MFMA32(a, b, c) __builtin_amdgcn_mfma_f32_32x32x16_bf16((a), (b), (c), 0, 0, 0)

#define SBAR() __builtin_amdgcn_sched_barrier(0)
#define CINIT16(P, S, C) asm volatile( \
    "v_mov_b32 %0, %17\n\tv_add_f32 %1, %16, %17\n\tv_fmamk_f32 %2, %16, 0x40000000, %17\n\tv_fmamk_f32 %3, %16, 0x40400000, %17\n\t" \
    "v_fmamk_f32 %4, %16, 0x41000000, %17\n\tv_fmamk_f32 %5, %16, 0x41100000, %17\n\tv_fmamk_f32 %6, %16, 0x41200000, %17\n\tv_fmamk_f32 %7, %16, 0x41300000, %17\n\t" \
    "v_fmamk_f32 %8, %16, 0x41800000, %17\n\tv_fmamk_f32 %9, %16, 0x41880000, %17\n\tv_fmamk_f32 %10, %16, 0x41900000, %17\n\tv_fmamk_f32 %11, %16, 0x41980000, %17\n\t" \
    "v_fmamk_f32 %12, %16, 0x41c00000, %17\n\tv_fmamk_f32 %13, %16, 0x41c80000, %17\n\tv_fmamk_f32 %14, %16, 0x41d00000, %17\n\tv_fmamk_f32 %15, %16, 0x41d80000, %17\n\ts_nop 1" \
    : "=&v"(P[0]), "=&v"(P[1]), "=&v"(P[2]), "=&v"(P[3]), "=&v"(P[4]), "=&v"(P[5]), "=&v"(P[6]), "=&v"(P[7]), \
      "=&v"(P[8]), "=&v"(P[9]), "=&v"(P[10]), "=&v"(P[11]), "=&v"(P[12]), "=&v"(P[13]), "=&v"(P[14]), "=&v"(P[15]) \
    : "v"(S), "v"(C))
__device__ __forceinline__ void glds16(const void* gsrc, unsigned lds_dst) { unsigned keep;
    asm volatile("s_mov_b32 %0, m0\n\ts_mov_b32 m0, %2\n\ts_nop 0\n\tglobal_load_lds_dwordx4 %1, off\n\ts_mov_b32 m0, %0" : "=&s"(keep) : "v"(gsrc), "s"(lds_dst) : "memory"); }
#define MX3(a, b, c) __builtin_fmaxf(__builtin_fmaxf((a), (b)), (c))
__device__ __forceinline__ void sweep(f32x16 (&o)[4], const bf16* Qm, const bf16* Km, const bf16* Vh, int q0, int NT, float sl, LAS unsigned char* lds, int tid, int wid, int lane, int r32, int hi) {
    const int q0w = q0 + wid * 32, qrow = q0w + r32;
    bf16x8 qr[4];
#pragma unroll
    for (int d0 = 0; d0 < 4; ++d0) qr[d0] = *(const bf16x8*)(Qm + (size_t)qrow * DM + d0 * 16 + hi * 8);
#pragma unroll
    for (int e = 0; e < 4; ++e)
#pragma unroll
        for (int i = 0; i < 16; ++i) o[e][i] = 0.f;
    float mhat = 0.f, lsum = 0.f;
    LAS float* wsf = (LAS float*)(lds + L_WSF) + wid * 64;
    const unsigned koff = (unsigned)(lane * DM + wid * 8);
    const unsigned voff0 = (unsigned)((16 * (wid & 3) + (lane >> 2)) * DM + (wid >> 2) * 32 + (lane & 3) * 8), voff1 = voff0 + 64;
#define ATT_STAGE(tt, bb) do { const bf16* Kt_ = Km + (size_t)(tt) * 64 * DM; const bf16* Vt_ = Vh + (size_t)(tt) * 64 * DM; \
        glds16(Kt_ + koff, ldsb + L_K + (bb) * 8192 + wid * 1024); glds16(Vt_ + voff0, ldsb + L_V + (bb) * 16384 + wid * 1024); glds16(Vt_ + voff1, ldsb + L_V + (bb) * 16384 + 8192 + wid * 1024); } while (0)
    const unsigned ldsb = (unsigned)(uintptr_t)lds;
    ATT_STAGE(0, 0);
    asm volatile("s_waitcnt vmcnt(0)" ::: "memory");
    __syncthreads();
    const int voff = ((lane >> 4) & 1) * 32 + (lane & 3) * 8 + (4 * hi + ((lane & 15) >> 2)) * 64;
    for (int t = 0; t < NT; ++t) {
        const int buf = t & 1;
        if (t + 1 < NT) ATT_STAGE(t + 1, buf ^ 1);
        if (64 * t <= q0w + 31) {
            const LAS unsigned char* Kb = lds + L_K + buf * 8192 + hi * 1024 + r32 * 16;
            const LAS unsigned char* Vb = lds + L_V + buf * 16384 + voff;
            bf16x8 kf[8];
#pragma unroll
            for (int d0 = 0; d0 < 4; ++d0) { kf[2 * d0] = *(const LAS bf16x8*)(Kb + d0 * 2048); kf[2 * d0 + 1] = *(const LAS bf16x8*)(Kb + d0 * 2048 + 512); }
            const float cb0 = sl * (float)(64 * t + 4 * hi - q0w) - mhat, cb1 = cb0 + 32.f * sl;
            f32x16 p0, p1;
            CINIT16(p0, sl, cb0); CINIT16(p1, sl, cb1);
            SBAR();
#pragma unroll
            for (int d0 = 0; d0 < 4; ++d0) { p0 = MFMA32(kf[2 * d0], qr[d0], p0); p1 = MFMA32(kf[2 * d0 + 1], qr[d0], p1); }
            s16x4 vl[2][4], vh[2][4];
#define RD_S(S, X) do { _Pragma("unroll") for (int e = 0; e < 4; ++e) { vl[X][e] = vtr(Vb + e * 4096 + (S) * 1024); vh[X][e] = vtr(Vb + e * 4096 + (S) * 1024 + 512); } } while (0)
#define PV_S(PA, X) do { _Pragma("unroll") for (int e = 0; e < 4; ++e) o[e] = MFMA32(PA, __builtin_shufflevector(vl[X][e], vh[X][e], 0, 1, 2, 3, 4, 5, 6, 7), o[e]); } while (0)
#define EXP8(P, B, PA) do { _Pragma("unroll") for (int j = 0; j < 8; ++j) { P[(B) + j] = __builtin_amdgcn_exp2f(P[(B) + j]); } \
        lsa += (P[(B)] + P[(B) + 1]) + (P[(B) + 2] + P[(B) + 3]); lsb += (P[(B) + 4] + P[(B) + 5]) + (P[(B) + 6] + P[(B) + 7]); \
        v4u w_; w_.x = pk2(P[(B)], P[(B) + 1]); w_.y = pk2(P[(B) + 2], P[(B) + 3]); w_.z = pk2(P[(B) + 4], P[(B) + 5]); w_.w = pk2(P[(B) + 6], P[(B) + 7]); PA = __builtin_bit_cast(bf16x8, w_); } while (0)
#define GAPS4() do { _Pragma("unroll") for (int g_ = 0; g_ < 4; ++g_) { __builtin_amdgcn_sched_group_barrier(0x008, 1, 0); __builtin_amdgcn_sched_group_barrier(0x002, 6, 0); __builtin_amdgcn_sched_group_barrier(0x100, 2, 0); } } while (0)
            RD_S(0, 0); RD_S(1, 1);
            SBAR();
            if (64 * t + 63 > q0w) {
                const int lim = qrow - 64 * t - 4 * hi;
#pragma unroll
                for (int i = 0; i < 16; ++i) { const int n_i = (i & 3) + 8 * (i >> 2); if (n_i > lim) p0[i] = -INFINITY; if (n_i + 32 > lim) p1[i] = -INFINITY; }
            }
            float ra = MX3(p0[0], p0[1], p1[0]), rb = MX3(p0[2], p0[3], p1[1]); ra = MX3(ra, p1[2], p1[3]);
#pragma unroll
            for (int i = 4; i < 16; i += 4) { ra = MX3(ra, p0[i], p0[i + 1]); rb = MX3(rb, p0[i + 2], p0[i + 3]); ra = MX3(ra, p1[i], p1[i + 1]); rb = MX3(rb, p1[i + 2], p1[i + 3]); }
            float rm = __builtin_fmaxf(ra, rb);
            { auto rr = __builtin_amdgcn_permlane32_swap(__float_as_uint(rm), __float_as_uint(rm), false, false); rm = __builtin_fmaxf(__uint_as_float(rr[0]), __uint_as_float(rr[1])); }
            if (t == 0 || __any(rm > 8.f)) {
                const float dl = (t == 0) ? rm : __builtin_fmaxf(rm, 0.f); mhat += dl;
#pragma unroll
                for (int i = 0; i < 16; ++i) { p0[i] -= dl; p1[i] -= dl; }
                if (t != 0) {
                    const float f = __builtin_amdgcn_exp2f(-dl); lsum *= f;
                    if (hi == 0) wsf[r32] = f;
                    asm volatile("s_waitcnt lgkmcnt(0)" ::: "memory");
#pragma unroll
                    for (int i = 0; i < 16; ++i) { const float fi = wsf[crow(i, hi)];
#pragma unroll
                        for (int e = 0; e < 4; ++e) o[e][i] *= fi; }
                }
            }
            float lsa = 0.f, lsb = 0.f; bf16x8 pa0, pa1, pa2, pa3;
            EXP8(p0, 0, pa0); SBAR();
            EXP8(p0, 8, pa1); PV_S(pa0, 0); RD_S(2, 0); GAPS4(); SBAR();
            EXP8(p1, 0, pa2); PV_S(pa1, 1); RD_S(3, 1); GAPS4(); SBAR();
            EXP8(p1, 8, pa3); PV_S(pa2, 0); GAPS4(); SBAR();
            PV_S(pa3, 1);
            lsum += lsa + lsb;
#undef RD_S
#undef PV_S
#undef EXP8
#undef GAPS4
        }
        asm volatile("s_waitcnt vmcnt(0)" ::: "memory");
        __syncthreads();
    }
    { auto rr = __builtin_amdgcn_permlane32_swap(__float_as_uint(lsum), __float_as_uint(lsum), false, false); lsum = __uint_as_float(rr[0]) + __uint_as_float(rr[1]); }
    if (hi == 0) wsf[32 + r32] = lsum;
    asm volatile("s_waitcnt lgkmcnt(0)" ::: "memory");
#pragma unroll
    for (int i = 0; i < 16; ++i) { const float rl = __builtin_amdgcn_rcpf(wsf[32 + crow(i, hi)]);
#pragma unroll
        for (int e = 0; e < 4; ++e) o[e][i] *= rl; }
    asm volatile("s_waitcnt lgkmcnt(0)" ::: "memory");
}

__device__ __forceinline__ void unit(int b, int h, int qb, bf16* Q, const bf16* K, const bf16* V, const bf16* ZA, const float* subg, float lam, LAS unsigned char* lds, bool dry = false) {
    const int tid = threadIdx.x, lane = tid & 63, r32 = lane & 31, hi = lane >> 5, wid = __builtin_amdgcn_readfirstlane(tid >> 6);
    const size_t rowbase = (size_t)b * SEQ; const int q0 = qb * 256, NT = 4 * (qb + 1);
    const float sl = exp2f(-(float)(h + 1)) * LOG2E;
    f32x16 o[4];
    LAS unsigned* stw = (LAS unsigned*)(lds + L_ST) + wid * 2048 + lane;
    sweep(o, Q + rowbase * DM + h * 128, K + rowbase * DM + h * 128, V + rowbase * DM + h * 128, q0, NT, sl, lds, tid, wid, lane, r32, hi);
#pragma unroll
    for (int e = 0; e < 4; ++e)
#pragma unroll
        for (int i = 0; i < 8; ++i) stw[(e * 8 + i) * 64] = pk2(o[e][2 * i], o[e][2 * i + 1]);
    sweep(o, Q + rowbase * DM + h * 128 + 64, K + rowbase * DM + h * 128 + 64, V + rowbase * DM + h * 128, q0, NT, sl, lds, tid, wid, lane, r32, hi);
    float ssq[16];
#pragma unroll
    for (int e = 0; e < 4; ++e)
#pragma unroll
        for (int i = 0; i < 8; ++i) { const unsigned w = stw[(e * 8 + i) * 64];
            o[e][2 * i] = bflo(w) - lam * o[e][2 * i]; o[e][2 * i + 1] = bfhi(w) - lam * o[e][2 * i + 1]; }
#pragma unroll
    for (int i = 0; i < 16; ++i) { float s = 0.f;
#pragma unroll
        for (int e = 0; e < 4; ++e) s += o[e][i] * o[e][i];
#pragma unroll
        for (int x = 1; x < 32; x <<= 1) s += __shfl_xor(s, x);
        ssq[i] = 0.8f / sqrtf(s * (1.f / 128.f) + 1e-5f); }
    asm volatile("s_waitcnt lgkmcnt(0)" ::: "memory");
    LAS bf16* stg = (LAS bf16*)(lds + L_ST) + wid * 4096;
#pragma unroll
    for (int e = 0; e < 4; ++e) { const float gs = subg[32 * e + r32];
#pragma unroll
        for (int i = 0; i < 16; ++i) stg[crow(i, hi) * 128 + 32 * e + r32] = (bf16)(pk2(o[e][i] * ssq[i] * gs, 0.f) & 0xffffu); }
    asm volatile("s_waitcnt lgkmcnt(0)" ::: "memory");
    bf16* Y = Q;
#pragma unroll
    for (int it = 0; it < 8; ++it) {
        const int row = it * 4 + (lane >> 4), ch = lane & 15;
        const size_t off = (rowbase + q0 + wid * 32 + row) * DM + h * 128 + ch * 8;
        const v4u yv = *(const LAS v4u*)(stg + row * 128 + ch * 8), zv = *(const v4u*)(ZA + off);
        v4u w;
        w.x = pk2(bflo(yv.x) * bflo(zv.x), bfhi(yv.x) * bfhi(zv.x)); w.y = pk2(bflo(yv.y) * bflo(zv.y), bfhi(yv.y) * bfhi(zv.y));
        w.z = pk2(bflo(yv.z) * bflo(zv.z), bfhi(yv.z) * bfhi(zv.z)); w.w = pk2(bflo(yv.w) * bflo(zv.w), bfhi(yv.w) * bfhi(zv.w));
        if (!dry) *(v4u*)(Y + off) = w;
    }
    asm volatile("s_waitcnt lgkmcnt(0)" ::: "memory");
}
}

namespace gm {
constexpr int L_VN = 0, L_ST = 32768;
__device__ __forceinline__ void unit(int chunk, int g, bf16* UZ, const bf16* GV, const float* part, const bf16* WSb, const float* lng, const float* lnb, const float* b_s, LAS unsigned char* lds, bool dry = false) {
    const int tid = threadIdx.x, lane = tid & 63, r32 = lane & 31, hi = lane >> 5, wid = __builtin_amdgcn_readfirstlane(tid >> 6);
    const size_t row0 = (size_t)chunk * 128;
    LAS float* stt = (LAS float*)(lds + L_ST);
    if (tid < 128) {
        const float* p = part + (row0 + tid) * 32; float s1 = 0.f, s2 = 0.f;
#pragma unroll
        for (int j = 0; j < 16; ++j) { s1 += p[2 * j]; s2 += p[2 * j + 1]; }
        const float mu = s1 * (1.f / 1024.f), var = fmaxf(s2 * (1.f / 1024.f) - mu * mu, 0.f);
        stt[2 * tid] = mu; stt[2 * tid + 1] = 1.0f / sqrtf(var + 1e-6f);
    }
    __syncthreads();
#pragma unroll
    for (int it = 0; it < 4; ++it) {
        const int idx = tid + 512 * it, s = idx >> 4, c16 = idx & 15;
        const v4u raw = *(const v4u*)(GV + (row0 + s) * DM + g * 128 + c16 * 8);
        const float mu = stt[2 * s], rs = stt[2 * s + 1];
        const f32x4 ga = *(const f32x4*)(lng + g * 128 + c16 * 8), gb = *(const f32x4*)(lng + g * 128 + c16 * 8 + 4);
        const f32x4 ba = *(const f32x4*)(lnb + g * 128 + c16 * 8), bb = *(const f32x4*)(lnb + g * 128 + c16 * 8 + 4);
        float v[8] = {bflo(raw.x), bfhi(raw.x), bflo(raw.y), bfhi(raw.y), bflo(raw.z), bfhi(raw.z), bflo(raw.w), bfhi(raw.w)};
#pragma unroll
        for (int j = 0; j < 4; ++j) { v[j] = (v[j] - mu) * rs * ga[j] + ba[j]; v[4 + j] = (v[4 + j] - mu) * rs * gb[j] + bb[j]; }
        v4u w; w.x = pk2(v[0], v[1]); w.y = pk2(v[2], v[3]); w.z = pk2(v[4], v[5]); w.w = pk2(v[6], v[7]);
        *(LAS v4u*)(lds + L_VN + (s >> 6) * 16384 + (c16 >> 2) * 4096 + (s & 63) * 64 + (c16 & 3) * 16) = w;
    }
    __syncthreads();
    const int tb = wid >> 1, db0 = 2 * (wid & 1);
    f32x16 acc[2];
#pragma unroll
    for (int i = 0; i < 16; ++i) { acc[0][i] = 0.f; acc[1][i] = 0.f; }
    const bf16* wrow = WSb + ((size_t)g * 128 + tb * 32 + r32) * 128;
    const int voff = ((lane >> 4) & 1) * 32 + (lane & 3) * 8 + (4 * hi + ((lane & 15) >> 2)) * 64;
#pragma unroll
    for (int ks = 0; ks < 8; ++ks) {
        if (ks * 16 > tb * 32 + 31) continue;
        const v2u a_lo = *(const v2u*)(wrow + 16 * ks + 4 * hi), a_hi = *(const v2u*)(wrow + 16 * ks + 8 + 4 * hi);
        const v4u aw = {a_lo.x, a_lo.y, a_hi.x, a_hi.y}; const bf16x8 af = __builtin_bit_cast(bf16x8, aw);
        const LAS unsigned char* Vb = lds + L_VN + (ks >> 2) * 16384 + (ks & 3) * 1024 + voff;
#pragma unroll
        for (int d = 0; d < 2; ++d) {
            const s16x4 lo = att::vtr(Vb + (db0 + d) * 4096), hh = att::vtr(Vb + (db0 + d) * 4096 + 512);
            const bf16x8 vf = __builtin_shufflevector(lo, hh, 0, 1, 2, 3, 4, 5, 6, 7);
            acc[d] = MFMA32(af, vf, acc[d]);
        }
    }
#pragma unroll
    for (int i = 0; i < 16; ++i) {
        const int t = tb * 32 + crow(i, hi); const float bs = b_s[g * 128 + t];
#pragma unroll
        for (int d = 0; d < 2; ++d) {
            const size_t off = (row0 + t) * DM + g * 128 + (db0 + d) * 32 + r32;
            const float uz = bflo((unsigned)UZ[off]);
            const float y = uz * (acc[d][i] + bs);
            if (!dry) UZ[off] = (bf16)(pk2(y, 0.f) & 0xffffu);
        }
    }
    __syncthreads();
}
}

#define XB_TMO      128
#define XB_XCNT(j)  (256  + 64 * (j))
#define XB_XSUB(j)  (1280 + 64 * (j))
#define XB_XGEN(j)  (2304 + 64 * (j))
#define XB_TOP      3328
#define XB_TOPGEN   3392
#define XCD_BAR_WORDS 3456
#define XB_SPIN_CAP (1u << 18)

__device__ __forceinline__ unsigned xb_ld(unsigned* p)              { return __hip_atomic_load(p, __ATOMIC_RELAXED, __HIP_MEMORY_SCOPE_AGENT); }
__device__ __forceinline__ unsigned xb_add(unsigned* p, unsigned v) { return __hip_atomic_fetch_add(p, v, __ATOMIC_RELAXED, __HIP_MEMORY_SCOPE_AGENT); }
__device__ __forceinline__ unsigned xb_xcc_id() { return (unsigned)__builtin_amdgcn_s_getreg((3 << 11) | 20) & 0xFu; }
#define XB_SPIN(cond, bar) do { unsigned _sp = 0; while (cond) { __builtin_amdgcn_s_sleep(1); \
    if ((++_sp & 255u) == 0u) { if (xb_ld(&(bar)[XB_TMO])) break; if (_sp > XB_SPIN_CAP) { atomicAdd(&(bar)[XB_TMO], 1u); break; } } } } while (0)

struct XcdBarrier {
    unsigned* bar; unsigned x;
    volatile LAS unsigned* st;
};

__device__ __forceinline__ XcdBarrier xcd_barrier_post(unsigned* bar, volatile LAS unsigned* st) {
    XcdBarrier b; b.bar = bar; b.x = xb_xcc_id(); b.st = st;
    if (threadIdx.x == 0) (void)xb_add(&bar[XB_XCNT(b.x)], 1u);
    return b;
}
__device__ __forceinline__ void xcd_barrier_complete(unsigned* bar, unsigned x, unsigned& nloc, unsigned& nx) {
    const unsigned G = gridDim.x * gridDim.y * gridDim.z;
    unsigned sum, cnt, mine, sp = 0u;
    for (;;) {
        sum = 0u; cnt = 0u; mine = 0u;
#pragma unroll
        for (unsigned j = 0; j < 16; ++j) { const unsigned c = xb_ld(&bar[XB_XCNT(j)]); sum += c; cnt += (c > 0u) ? 1u : 0u; mine = (j == x) ? c : mine; }
        if (sum == G) break;
        __builtin_amdgcn_s_sleep(1);
        if ((++sp & 255u) == 0u) { if (xb_ld(&bar[XB_TMO])) break; if (sp > XB_SPIN_CAP) { atomicAdd(&bar[XB_TMO], 1u); break; } }
    }
    nloc = mine > 0u ? mine : 1u; nx = cnt > 0u ? cnt : 1u;
}

__device__ __forceinline__ void xcd_barrier(const XcdBarrier& b) {
    asm volatile("s_waitcnt vmcnt(0)" ::: "memory");
    __syncthreads();
    if (threadIdx.x == 0) {
        unsigned* bar = b.bar;
        __builtin_amdgcn_s_waitcnt(0);
        unsigned nloc = b.st[0], nx = b.st[1];
        if (nloc == 0u) { xcd_barrier_complete(bar, b.x, nloc, nx); b.st[0] = nloc; b.st[1] = nx; }
        const unsigned old = xb_add(&bar[XB_XSUB(b.x)], 1u);
        const unsigned gen = old / nloc;
        if (old + 1u == (gen + 1u) * nloc) {
            __builtin_amdgcn_fence(__ATOMIC_RELEASE, "agent");
            asm volatile("s_waitcnt vmcnt(0)" ::: "memory");
            const unsigned og = xb_add(&bar[XB_TOP], 1u);
            const unsigned tg = og / nx;
            if (og + 1u == (tg + 1u) * nx) xb_add(&bar[XB_TOPGEN], 1u);
            else XB_SPIN(xb_ld(&bar[XB_TOPGEN]) == tg, bar);
            __builtin_amdgcn_fence(__ATOMIC_ACQUIRE, "agent");
            xb_add(&bar[XB_XGEN(b.x)], 1u);
            asm volatile("s_waitcnt vmcnt(0)" ::: "memory");
        } else {
            XB_SPIN(xb_ld(&bar[XB_XGEN(b.x)]) == gen, bar);
            __builtin_amdgcn_fence(__ATOMIC_ACQUIRE, "agent");
            asm volatile("s_waitcnt vmcnt(0)" ::: "memory");
        }
    }
    __syncthreads();
}

__global__ void __launch_bounds__(NTHREADS, 2) fwd_kernel(Args args) {
    extern __shared__ __attribute__((aligned(16))) unsigned char lds_raw[];
    LAS unsigned char* lds = (LAS unsigned char*)lds_raw;
    cg::grid_group grid = cg::this_grid();
    const int tid = threadIdx.x, lane = tid & 63, wave = __builtin_amdgcn_readfirstlane(tid >> 6);
    const int G = gridDim.x, bx = blockIdx.x, vcu = (G % 8 == 0) ? (bx % 8) * (G / 8) + bx / 8 : bx;
    unsigned char* ws = args.ws;
    const int lo = args.ph_lo, hi_ph = args.ph_hi;
#define IN(k) (lo <= (k) && (k) < hi_ph)
    for (int u = tid; u < (LDS_BYTES - LDSCTL_OFF) / 4; u += NTHREADS) ((LAS unsigned*)(lds + LDSCTL_OFF))[u] = 0u;
    __syncthreads();
    XcdBarrier bar = xcd_barrier_post((unsigned*)(ws + WS_CTL) + CW_BAR, (volatile LAS unsigned*)(lds + MISC_OFF) + 8);
    if (args.ph_hi > 1000) grid.sync();
#define SEAM(k) do { if (IN(k) && IN((k) + 1)) xcd_barrier(bar); } while (0)
    bf16 *Hb = (bf16*)(ws + WS_H), *Qb = (bf16*)(ws + WS_Q), *Kb = (bf16*)(ws + WS_K), *Vb = (bf16*)(ws + WS_V), *ZAb = (bf16*)(ws + WS_ZA), *UZb = (bf16*)(ws + WS_UZ), *GVb = (bf16*)(ws + WS_GV);
    bf16 *GAb = (bf16*)args.out, *GBb = (bf16*)args.out + (size_t)M * DM;
    float* part = (float*)(ws + WS_PART); float* part2 = (float*)(ws + WS_PART2);

    if (IN(0)) { p0_prologue(args, lds, vcu, G, wave, lane); }
    SEAM(0);
    if (IN(1)) {
        pg8::Gemm g{Hb, (const bf16*)(ws + WS_WTIN), M, NIN, DM}; pg8::StaticOrder S; S.init(M, NIN, G, bx);
        EpiInProj E{Qb, Kb, Vb, ZAb, UZb, GVb, GAb, GBb, part};
        pg8::gemm_phase<EpiInProj, pg8::StaticOrder, true, true>(lds, g, S, E);
    }
    SEAM(1);
    if (IN(2)) {
        const float lam = ((const float*)(ws + WS_LAM))[0];
        for (int pi = vcu; pi < 256; pi += G) {
            const int bh = pi >> 3, s = pi & 7;
#ifndef NO_ATT
            att::unit(bh >> 3, bh & 7, 15 - s, Qb, Kb, Vb, ZAb, args.in[7], lam, lds);
            att::unit(bh >> 3, bh & 7, s, Qb, Kb, Vb, ZAb, args.in[7], lam, lds);
#endif
        }
        for (int u = vcu; u < 1024; u += G) gm::unit(u >> 3, u & 7, UZb, GVb, part, (const bf16*)(ws + WS_WS), args.in[8], args.in[9], args.in[11], lds);
    }
    if (IN(6)) {
        const float lam = ((const float*)(ws + WS_LAM))[0];
        for (int pi = vcu; pi < 256; pi += G) { const int bh = pi >> 3, s = pi & 7;
            att::unit(bh >> 3, bh & 7, 15 - s, Qb, Kb, Vb, ZAb, args.in[7], lam, lds, true); att::unit(bh >> 3, bh & 7, s, Qb, Kb, Vb, ZAb, args.in[7], lam, lds, true); }
    }
    if (IN(7)) {
        for (int u = vcu; u < 1024; u += G) gm::unit(u >> 3, u & 7, UZb, GVb, part, (const bf16*)(ws + WS_WS), args.in[8], args.in[9], args.in[11], lds, true);
    }
    SEAM(2);
    if (IN(3)) {
        static_assert(WS_UZ - WS_Q == (size_t)256 * 256 * DM * 2 && WS_WTB - WS_WTA == (size_t)4 * 256 * DM * 2, "chained merge units address y_b / W_b^T as tile offsets of y_a / W_a^T");
        pg8::Gemm g{Qb, (const bf16*)(ws + WS_WTA), M, DM, DM}; MergeOrder S; S.init(G, bx); EpiMergeChain E{GAb, GBb, Hb};
        pg8::gemm_phase<EpiMergeChain, MergeOrder, true, true>(lds, g, S, E);
    }
    SEAM(3);
    if (IN(4)) {
        pg8::Gemm g{Hb, (const bf16*)(ws + WS_WTO), M, DM, DM}; pg8::StaticOrder S; S.init(M, DM, G, bx); EpiOut E{args.in[0], args.out, part2};
        pg8::gemm_phase<EpiOut, pg8::StaticOrder, true, true>(lds, g, S, E);
    }
    SEAM(4);
    if (IN(5)) {
        const int gw = vcu * NWAVES + wave, NGW = G * NWAVES; const float* fg = args.in[15];
        f32x4 g4[4];
#pragma unroll
        for (int j = 0; j < 4; ++j) g4[j] = ((const f32x4*)fg)[64 * j + lane];
        for (int m = gw; m < M; m += NGW) {
            float s = (lane < 16) ? part2[(size_t)m * 16 + lane] : 0.f;
            s = wave_sum(s);
            const float rstd = 1.0f / sqrtf(s * (1.f / DM) + 1e-6f);
            f32x4* xr = (f32x4*)(args.out + (size_t)m * DM) + lane;
#pragma unroll
            for (int j = 0; j < 4; ++j) xr[64 * j] = xr[64 * j] * rstd * g4[j];
        }
    }
#undef IN
#undef SEAM
}

extern "C" void kernel_launch(void* const* d_in, const int* in_sizes, int n_in, void* d_out, int out_size, void* d_ws, size_t ws_size, hipStream_t stream) {
    static int grid = 0;
    if (grid == 0) {
        if (n_in != 16 || out_size != M * DM || ws_size < WS_END) { fprintf(stderr, "kernel_launch: unexpected shapes (n_in %d out %d ws %zu)\n", n_in, out_size, ws_size); grid = -1; return; }
        int dev = 0, cus = 0, per_cu = 0;
        hipGetDevice(&dev); hipDeviceGetAttribute(&cus, hipDeviceAttributeMultiprocessorCount, dev);
        hipFuncSetAttribute((const void*)fwd_kernel, hipFuncAttributeMaxDynamicSharedMemorySize, LDS_BYTES);
        hipOccupancyMaxActiveBlocksPerMultiprocessor(&per_cu, (const void*)fwd_kernel, NTHREADS, LDS_BYTES);
        if (per_cu < 1) per_cu = 1;
        grid = cus * per_cu;
        (void)hipGetLastError();
    }
    if (grid < 0) return;
    (void)hipMemsetAsync((char*)d_ws + WS_CTL, 0, CTL_ZERO_BYTES, stream);
    Args a{};
    for (int i = 0; i < 16; ++i) a.in[i] = (const float*)d_in[i];
    a.out = (float*)d_out; a.ws = (unsigned char*)d_ws;
#if MK_N_LAUNCHES == 1
    a.ph_lo = 0; a.ph_hi = N_PHASES;
    void* kargs[] = {&a};
    hipError_t e = hipLaunchCooperativeKernel((const void*)fwd_kernel, dim3(grid), dim3(NTHREADS), kargs, LDS_BYTES, stream);
    if (e != hipSuccess) fprintf(stderr, "cooperative launch failed: %s (grid %d)\n", hipGetErrorString(e), grid);
#else
    { const int seq[] = {PROBE_SEQ};
      for (int i = 0; i < (int)(sizeof(seq) / sizeof(int)); ++i) { a.ph_lo = seq[i]; a.ph_hi = seq[i] + 1; hipLaunchKernelGGL(fwd_kernel, dim3(grid), dim3(NTHREADS), LDS_BYTES, stream, a); } }
#endif
}
```
